# Optimizing an MI355X kernel written in HIP

```python
import math
import jax, jax.numpy as jnp
from jax import lax
import numpy as np

D_MODEL = 1024
BATCH = 2
SEQ = 8192
DEPTH = 1

HEAD_DIM = 64
FOX_HEADS = 8
SB_HEADS = 8
FOX_WIDTH = FOX_HEADS * HEAD_DIM
SB_WIDTH = SB_HEADS * HEAD_DIM
MIX_WIDTH = FOX_WIDTH + SB_WIDTH
IN_COLS = 3 * FOX_WIDTH + FOX_HEADS + 3 * SB_WIDTH
Q_BLOCK = 128
FORGET_BIAS_INIT = 3.0
N_EXPERTS = 32
TOP_K = 4
D_FF = D_MODEL
SWIGLU_LIMIT = 7.0
SWIGLU_ALPHA = 1.702
EXPERT_BLOCK = 128
NORM_EPS = 1e-5

kernel_name = "hybrid_fox_stickbreak_moe_layer"


def rmsnorm(x, g):
    xf = x.astype(jnp.float32)
    y = xf * lax.rsqrt(jnp.mean(xf * xf, axis=-1, keepdims=True) + NORM_EPS)
    return (y * g.astype(jnp.float32)).astype(x.dtype)


def to_query_blocks(t):
    b, s, h, d = t.shape
    return t.reshape(b, s // Q_BLOCK, Q_BLOCK, h, d).transpose(1, 0, 2, 3, 4)


def from_query_blocks(t):
    nb, b, qb, h, d = t.shape
    return t.transpose(1, 0, 2, 3, 4).reshape(b, nb * qb, h * d)


def forgetting_attention(q, k, v, log_f):
    b, s, h, d = q.shape
    scale = 1.0 / math.sqrt(d)
    c = jnp.cumsum(log_f.astype(jnp.float32), axis=1).transpose(0, 2, 1)
    nb = s // Q_BLOCK
    c_q = c.reshape(b, h, nb, Q_BLOCK).transpose(2, 0, 1, 3)
    kpos = jnp.arange(s)

    def block(args):
        qb, cqb, i = args
        logits = jnp.einsum('bqhd,bkhd->bhqk', qb, k).astype(jnp.float32) * scale
        logits = logits + cqb[..., None] - c[:, :, None, :]
        qpos = i * Q_BLOCK + jnp.arange(Q_BLOCK)
        causal = kpos[None, :] <= qpos[:, None]
        logits = jnp.where(causal, logits, -jnp.inf)
        p = jax.nn.softmax(logits, axis=-1).astype(v.dtype)
        return jnp.einsum('bhqk,bkhd->bqhd', p, v)

    out = lax.map(block, (to_query_blocks(q), c_q, jnp.arange(nb)))
    return from_query_blocks(out)


def stick_breaking_attention(q, k, v):
    b, s, h, d = q.shape
    scale = 1.0 / math.sqrt(d)
    nb = s // Q_BLOCK
    kpos = jnp.arange(s)

    def block(args):
        qb, i = args
        z = jnp.einsum('bqhd,bkhd->bhqk', qb, k).astype(jnp.float32) * scale
        qpos = i * Q_BLOCK + jnp.arange(Q_BLOCK)
        strict = kpos[None, :] < qpos[:, None]
        log_beta = jax.nn.log_sigmoid(z)
        log_1m = jnp.where(strict, jax.nn.log_sigmoid(-z), 0.0)
        suffix = lax.cumsum(log_1m, axis=3, reverse=True) - log_1m
        a = jnp.where(strict, jnp.exp(log_beta + suffix), 0.0).astype(v.dtype)
        return jnp.einsum('bhqk,bkhd->bqhd', a, v)

    out = lax.map(block, (to_query_blocks(q), jnp.arange(nb)))
    return from_query_blocks(out)


def moe_ffn(h, w_router, b_router, w_gate_up, b_gate_up, w_down, b_down):
    t, d = h.shape
    n_assign = t * TOP_K
    logits = (h @ w_router).astype(jnp.float32) + b_router.astype(jnp.float32)
    top_vals, top_idx = lax.top_k(logits, TOP_K)
    gates = jax.nn.softmax(top_vals, axis=-1).astype(h.dtype)

    flat_e = top_idx.reshape(-1)
    flat_tok = jnp.arange(n_assign, dtype=jnp.int32) // TOP_K
    flat_w = gates.reshape(-1)
    order = jnp.argsort(flat_e)
    sorted_e = flat_e[order]
    sorted_tok = flat_tok[order]
    sorted_w = flat_w[order]

    counts = jnp.bincount(flat_e, length=N_EXPERTS)
    starts = jnp.cumsum(counts) - counts
    padded_counts = (counts + EXPERT_BLOCK - 1) // EXPERT_BLOCK * EXPERT_BLOCK
    padded_ends = jnp.cumsum(padded_counts)
    padded_starts = padded_ends - padded_counts
    rank = jnp.arange(n_assign) - starts[sorted_e]
    dest = padded_starts[sorted_e] + rank

    n_pad = (n_assign + N_EXPERTS * (EXPERT_BLOCK - 1) + EXPERT_BLOCK - 1) // EXPERT_BLOCK * EXPERT_BLOCK
    n_blocks = n_pad // EXPERT_BLOCK
    row_tok = jnp.full((n_pad,), t, dtype=jnp.int32).at[dest].set(sorted_tok)
    row_w = jnp.zeros((n_pad,), h.dtype).at[dest].set(sorted_w)
    block_start = jnp.arange(n_blocks) * EXPERT_BLOCK
    block_e = jnp.minimum(jnp.searchsorted(padded_ends, block_start, side='right'), N_EXPERTS - 1)

    h_pad = jnp.concatenate([h, jnp.zeros((1, d), h.dtype)], axis=0)
    xs = h_pad[row_tok].reshape(n_blocks, EXPERT_BLOCK, d)

    def expert_block(args):
        xb, e = args
        gu = xb @ w_gate_up[e] + b_gate_up[e]
        gate = jnp.minimum(gu[:, 0::2], SWIGLU_LIMIT)
        up = jnp.clip(gu[:, 1::2], -SWIGLU_LIMIT, SWIGLU_LIMIT)
        act = gate * jax.nn.sigmoid(SWIGLU_ALPHA * gate) * (up + 1.0)
        return act @ w_down[e] + b_down[e]

    ys = lax.map(expert_block, (xs, block_e)).reshape(n_pad, d)
    out = jax.ops.segment_sum(ys * row_w[:, None], row_tok, num_segments=t + 1)
    return out[:t]


def setup_inputs(seed: int = 0) -> dict:
    key = jax.random.key(seed)
    ks = jax.random.split(key, 16)
    f32 = jnp.float32
    nrm = lambda k, shp, s: jax.random.normal(k, shp, f32) * s
    return {
        "x": nrm(ks[0], (BATCH, SEQ, D_MODEL), 1.0),
        "attn_norm_g": 1.0 + nrm(ks[1], (D_MODEL,), 0.02),
        "w_in": nrm(ks[2], (D_MODEL, IN_COLS), D_MODEL ** -0.5),
        "b_forget": FORGET_BIAS_INIT + nrm(ks[3], (FOX_HEADS,), 0.1),
        "fox_out_g": 1.0 + nrm(ks[4], (FOX_WIDTH,), 0.02),
        "sb_out_g": 1.0 + nrm(ks[5], (SB_WIDTH,), 0.02),
        "w_out": nrm(ks[6], (MIX_WIDTH, D_MODEL), MIX_WIDTH ** -0.5),
        "ffn_norm_g": 1.0 + nrm(ks[7], (D_MODEL,), 0.02),
        "w_router": nrm(ks[8], (D_MODEL, N_EXPERTS), D_MODEL ** -0.5),
        "b_router": nrm(ks[9], (N_EXPERTS,), 0.01),
        "w_gate_up": nrm(ks[10], (N_EXPERTS, D_MODEL, 2 * D_FF), D_MODEL ** -0.5),
        "b_gate_up": nrm(ks[11], (N_EXPERTS, 2 * D_FF), 0.01),
        "w_down": nrm(ks[12], (N_EXPERTS, D_FF, D_MODEL), D_FF ** -0.5),
        "b_down": nrm(ks[13], (N_EXPERTS, D_MODEL), 0.01),
        "final_norm_g": 1.0 + nrm(ks[14], (D_MODEL,), 0.02),
    }


def reference(x, attn_norm_g, w_in, b_forget, fox_out_g, sb_out_g, w_out, ffn_norm_g,
              w_router, b_router, w_gate_up, b_gate_up, w_down, b_down, final_norm_g):
    b, s, d = x.shape
    for _ in range(DEPTH):
        h = rmsnorm(x, attn_norm_g)
        proj = h @ w_in
        o = 0
        q_a = proj[..., o:o + FOX_WIDTH].reshape(b, s, FOX_HEADS, HEAD_DIM); o += FOX_WIDTH
        k_a = proj[..., o:o + FOX_WIDTH].reshape(b, s, FOX_HEADS, HEAD_DIM); o += FOX_WIDTH
        v_a = proj[..., o:o + FOX_WIDTH].reshape(b, s, FOX_HEADS, HEAD_DIM); o += FOX_WIDTH
        f_logit = proj[..., o:o + FOX_HEADS]; o += FOX_HEADS
        q_b = proj[..., o:o + SB_WIDTH].reshape(b, s, SB_HEADS, HEAD_DIM); o += SB_WIDTH
        k_b = proj[..., o:o + SB_WIDTH].reshape(b, s, SB_HEADS, HEAD_DIM); o += SB_WIDTH
        v_b = proj[..., o:o + SB_WIDTH].reshape(b, s, SB_HEADS, HEAD_DIM)

        log_f = jax.nn.log_sigmoid((f_logit + b_forget).astype(jnp.float32))
        y_a = rmsnorm(forgetting_attention(q_a, k_a, v_a, log_f), fox_out_g)
        y_b = rmsnorm(stick_breaking_attention(q_b, k_b, v_b), sb_out_g)
        x = x + jnp.concatenate([y_a, y_b], axis=-1) @ w_out

        h2 = rmsnorm(x, ffn_norm_g).reshape(b * s, d)
        x = x + moe_ffn(h2, w_router, b_router, w_gate_up, b_gate_up, w_down, b_down).reshape(b, s, d)
    return rmsnorm(x, final_norm_g)
```

```cpp
#include <hip/hip_runtime.h>
#include <cstdio>
#include <cstdint>

#define GAS __attribute__((address_space(1)))
#define LAS __attribute__((address_space(3)))
typedef unsigned short bf16;
typedef float f32x4 __attribute__((ext_vector_type(4)));
typedef unsigned v4u __attribute__((ext_vector_type(4)));
typedef unsigned v2u __attribute__((ext_vector_type(2)));
typedef GAS unsigned gu32;
#define RLX_AGENT __ATOMIC_RELAXED, __HIP_MEMORY_SCOPE_AGENT
#define LDS_WAIT() asm volatile("s_waitcnt lgkmcnt(0)" ::: "memory")
#define VM_WAIT() asm volatile("s_waitcnt vmcnt(0)" ::: "memory")

constexpr int BATCH = 2, SEQ = 8192, D = 1024, M = BATCH * SEQ, NH = 16  , HD = 64;
constexpr int INC = 3080, NE = 32, TOPK = 4, DFF = 1024;
constexpr float EPS = 1e-5f, LOG2E = 1.4426950408889634f, C2 = 0.125f * 1.4426950408889634f;
constexpr int MAXTILES = 288, MAXROWS = MAXTILES * 256;
constexpr int NWAVES = 8, NTHR = 512;
constexpr float W8_SCALE = 64.f, X8_SCALE = 16.f, A8_SCALE = 8.f, Y8_SCALE = 32.f;
constexpr int NVB = 256, VBT = M / NVB;

constexpr size_t MiB = 1u << 20;
constexpr size_t WS_CTL = 0, CTL_ZERO_BYTES = 64 * 1024;
constexpr size_t WS_WIN = 2 * MiB, WS_WOUT = 8 * MiB, WS_WGU = 16 * MiB, WS_WD = 144 * MiB;
constexpr size_t WS_XN = 208 * MiB;
constexpr size_t WS_SSQ = 240 * MiB;
constexpr size_t WS_LOGF = 241 * MiB, WS_CL = WS_LOGF + 512 * 1024;
constexpr size_t WS_TOPE = 242 * MiB, WS_GATE = WS_TOPE + 256 * 1024, WS_SLOT = WS_GATE + 256 * 1024, WS_GSLOT = WS_SLOT + 256 * 1024;
constexpr size_t WS_CNT = 243 * MiB + 256 * 1024, WS_TILE = 243 * MiB + 512 * 1024;
constexpr size_t WS_ROWTOK = 244 * MiB, WS_ROWDST = WS_ROWTOK + 512 * 1024, WS_GSLOT2 = WS_ROWDST + 512 * 1024;
constexpr size_t WS_Q = 256 * MiB, WS_K = 288 * MiB, WS_V = 320 * MiB;
constexpr size_t WS_O = 352 * MiB;
constexpr size_t WS_XS = 256 * MiB;
constexpr size_t WS_ACT = 400 * MiB;
constexpr size_t WS_XS8 = 480 * MiB;
constexpr size_t WS_X1 = 560 * MiB;
constexpr size_t WS_END = 624 * MiB;
constexpr int CW_BAR = 4096, CW_KN = 8192;
#ifndef ATT_PRUNE
#define ATT_PRUNE 1
#endif

constexpr int LDS_BYTES = 147456;
constexpr int MISC_OFF = LDS_BYTES - 128;

__device__ __forceinline__ unsigned f2bf(float f) { unsigned u = __builtin_bit_cast(unsigned, f); return (u + 0x7fffu + ((u >> 16) & 1u)) >> 16; }
__device__ __forceinline__ unsigned pk2(float lo, float hi) { return f2bf(lo) | (f2bf(hi) << 16); }
typedef unsigned v2u_b __attribute__((ext_vector_type(2)));
__device__ __forceinline__ f32x4 bf4(v2u_b w) { return (f32x4){__uint_as_float(w.x << 16), __uint_as_float(w.x & 0xffff0000u), __uint_as_float(w.y << 16), __uint_as_float(w.y & 0xffff0000u)}; }
__device__ __forceinline__ float bflo(unsigned w) { return __builtin_bit_cast(float, w << 16); }
__device__ __forceinline__ float bfhi(unsigned w) { return __builtin_bit_cast(float, w & 0xffff0000u); }
__device__ __forceinline__ float wave_sum(float v) {
#pragma unroll
    for (int o = 1; o < 64; o <<= 1) v += __shfl_xor(v, o);
    return v;
}

namespace pg8 {
#define PG8_LAS __attribute__((address_space(3)))
typedef unsigned short bf16_t;
typedef short bf16x8 __attribute__((ext_vector_type(8)));
typedef float f32x4 __attribute__((ext_vector_type(4)));
typedef unsigned u32x4 __attribute__((ext_vector_type(4)));
typedef unsigned u32x2 __attribute__((ext_vector_type(2)));
typedef int i32x4_t __attribute__((ext_vector_type(4)));
constexpr int BM = 256, BK = 64, HALF = 128, HTB = HALF * BK * 2  , STAGE_BYTES = 8 * HTB, NXCD = 8, WGM = 8;

__host__ __device__ __forceinline__ int lds_byte(int r, int c) { const int st = (r >> 4) * 2 + (c >> 5), rr = r & 15, cc = c & 31, ob = rr * 64 + cc * 2; return st * 1024 + (ob ^ (((ob >> 9) & 1) << 5)); }
__host__ __device__ __forceinline__ void stage_rc(int b, int& R, int& C) { const int st = b / 1024, sb = b % 1024, swz = sb ^ (((sb >> 9) & 1) << 5); R = (st >> 1) * 16 + swz / 64; C = (st & 1) * 32 + (swz % 64) / 2; }
__host__ __device__ __forceinline__ int perm32(int rho) { const int n = rho >> 4, i = rho & 15; return 8 * (i >> 2) + 4 * n + (i & 3); }

struct Unit { int pm, pn; };
struct Gemm { const bf16_t* A; const bf16_t* Bt; int M, N, K; };

struct StaticOrder {
    int nM, nN, nwg, G, c;
    __host__ __device__ void init(int M, int N, int G_, int c_) { nM = M / BM; nN = N / BM; nwg = nM * nN; G = G_; c = c_; }
    __host__ __device__ bool next(int i, Unit& u) const {
        const long L = (long)i * G + c; if (L >= nwg) return false;
        int wgid = (int)L; { const int q = nwg / NXCD, r = nwg % NXCD, xcd = wgid % NXCD, off = wgid / NXCD; wgid = (xcd < r ? xcd * (q + 1) : r * (q + 1) + (xcd - r) * q) + off; }
        const int nig = WGM * nN, gid = wgid / nig, fm = gid * WGM, gsz = (nM - fm) < WGM ? (nM - fm) : WGM;
        u.pm = fm + ((wgid % nig) % gsz); u.pn = (wgid % nig) / gsz; return true;
    }
    __device__ __forceinline__ void a_ready(const Unit&) const {}
    __device__ __forceinline__ void done(const Unit&) const {}
};
__device__ __forceinline__ unsigned cvt_pk_bf16(float lo, float hi) { unsigned r; asm volatile("v_cvt_pk_bf16_f32 %0, %1, %2" : "=v"(r) : "v"(lo), "v"(hi)); return r; }
typedef float f32x2 __attribute__((ext_vector_type(2)));
__device__ __forceinline__ f32x2 gelu_pk(f32x2 v) {
    const f32x2 av = __builtin_elementwise_abs(v), d = av * 0.2316418882f + 1.0f;
    f32x2 t; t.x = __builtin_amdgcn_rcpf(d.x); t.y = __builtin_amdgcn_rcpf(d.y);
    f32x2 q = t * 0.5307027145f + (-0.7265760135f); q = q * t + 0.7107068705f; q = q * t + (-0.142248368f); q = q * t + 0.127414796f; q = q * t;
    const f32x2 s = (v * v) * (-0.72134752044f);
    f32x2 e; e.x = __builtin_amdgcn_exp2f(s.x); e.y = __builtin_amdgcn_exp2f(s.y);
    const f32x2 m = v * (q * e), r = v - m;
    f32x2 o; o.x = v.x < 0.f ? m.x : r.x; o.y = v.y < 0.f ? m.y : r.y; return o;
}

template <int ACT  > struct EpiBf16 {
    static constexpr bool PERM = true, AFTER_DRAIN = false, MIDK = false; static_assert(ACT == 0 || ACT == 1, "EpiBf16: ACT is 0 (none) or 1 (gelu_pk)");
    bf16_t* O; int ldc; const float* bias; int split_cols; size_t split_stride; float scale0;
    __device__ __forceinline__ void operator()(const f32x4 (&acc)[2][2][4][2], const Unit& u, int wr, int wc, int fr, int fq) const {
        const int row0 = u.pm * BM + wr * 64 + fr; int colt = u.pn * BM; bf16_t* base = O;
        float sc = 1.f; if (split_cols) { const int t = colt / split_cols; base += (size_t)t * split_stride; colt -= t * split_cols; if (t == 0) sc = scale0; }
        const int col0 = colt + wc * 32 + 8 * fq, bcol0 = u.pn * BM + wc * 32 + 8 * fq;
        f32x4 bv[2][2];
#pragma unroll
        for (int bj = 0; bj < 2; ++bj)
#pragma unroll
            for (int n = 0; n < 2; ++n) bv[bj][n] = bias ? *(const f32x4*)(bias + bcol0 + bj * HALF + 4 * n) : (f32x4){0.f, 0.f, 0.f, 0.f};
#pragma unroll
        for (int ai = 0; ai < 2; ++ai)
#pragma unroll
            for (int m = 0; m < 4; ++m) { bf16_t* rowp = base + (size_t)(row0 + ai * HALF + m * 16) * ldc + col0;
#pragma unroll
                for (int bj = 0; bj < 2; ++bj) { f32x4 v0 = acc[ai][bj][m][0] + bv[bj][0], v1 = acc[ai][bj][m][1] + bv[bj][1];
                    if (ACT == 1) { f32x2 a = gelu_pk((f32x2){v0[0], v0[1]}), b = gelu_pk((f32x2){v0[2], v0[3]}), c = gelu_pk((f32x2){v1[0], v1[1]}), d = gelu_pk((f32x2){v1[2], v1[3]});
                        v0 = (f32x4){a.x, a.y, b.x, b.y}; v1 = (f32x4){c.x, c.y, d.x, d.y}; }
                    v0 = v0 * sc; v1 = v1 * sc; u32x4 w; w.x = cvt_pk_bf16(v0[0], v0[1]); w.y = cvt_pk_bf16(v0[2], v0[3]); w.z = cvt_pk_bf16(v1[0], v1[1]); w.w = cvt_pk_bf16(v1[2], v1[3]);
                    *(u32x4*)(rowp + bj * HALF) = w; } }
    }
};

struct EpiResF32 { static constexpr bool PERM = false, AFTER_DRAIN = false, MIDK = false; const float* base; float* out; int ldc;
    __device__ __forceinline__ void operator()(const f32x4 (&acc)[2][2][4][2], const Unit& u, int wr, int wc, int fr, int fq) const {
        const int col0 = u.pn * BM + wc * 32 + 4 * fq;
#pragma unroll
        for (int ai = 0; ai < 2; ++ai)
#pragma unroll
            for (int m = 0; m < 4; ++m) { const size_t off = (size_t)(u.pm * BM + ai * HALF + wr * 64 + m * 16 + fr) * ldc + col0;
#pragma unroll
                for (int bj = 0; bj < 2; ++bj)
#pragma unroll
                    for (int n = 0; n < 2; ++n) { const f32x4 b = *(const f32x4*)(base + off + bj * HALF + n * 16); *(f32x4*)(out + off + bj * HALF + n * 16) = b + acc[ai][bj][m][n]; } }
    } };

struct EpiResMid { static constexpr bool PERM = false, AFTER_DRAIN = false, MIDK = true; const float* base; unsigned short* out; int ldc; const float* ssq; PG8_LAS float* tab;
    __device__ __forceinline__ void prep(const Unit& u, int par, int tid) const {
        if (tid < 256) { const f32x4* sp = (const f32x4*)(ssq + (size_t)(u.pm * BM + tid) * 16); const f32x4 s0 = sp[0], s1 = sp[1], s2 = sp[2], s3 = sp[3];
            const float sa = (s0[0] + s0[1]) + (s0[2] + s0[3]) + (s1[0] + s1[1]) + (s1[2] + s1[3]), sb = (s2[0] + s2[1]) + (s2[2] + s2[3]) + (s3[0] + s3[1]) + (s3[2] + s3[3]);
            const float rsa = 1.0f / sqrtf(sa * (1.f / 512.f) + 1e-5f), rsb = 1.0f / sqrtf(sb * (1.f / 512.f) + 1e-5f);
            tab[(par * 256 + tid) * 2] = rsa / rsb; tab[(par * 256 + tid) * 2 + 1] = rsb; } }
    __device__ __forceinline__ void midk(f32x4 (&acc)[2][2][4][2], int par, int wr, int fr) const {
#pragma unroll
        for (int ai = 0; ai < 2; ++ai)
#pragma unroll
            for (int m = 0; m < 4; ++m) { const float f = tab[(par * 256 + ai * HALF + wr * 64 + m * 16 + fr) * 2];
#pragma unroll
                for (int bj = 0; bj < 2; ++bj)
#pragma unroll
                    for (int n = 0; n < 2; ++n) acc[ai][bj][m][n] *= f; } }
    __device__ __forceinline__ void epi(const f32x4 (&acc)[2][2][4][2], const Unit& u, int par, int wr, int wc, int fr, int fq) const {
        const int col0 = u.pn * BM + wc * 32 + 4 * fq;
#pragma unroll
        for (int ai = 0; ai < 2; ++ai)
#pragma unroll
            for (int m = 0; m < 4; ++m) { const int r = ai * HALF + wr * 64 + m * 16 + fr; const float f = tab[(par * 256 + r) * 2 + 1]; const size_t off = (size_t)(u.pm * BM + r) * ldc + col0;
#pragma unroll
                for (int bj = 0; bj < 2; ++bj)
#pragma unroll
                    for (int n = 0; n < 2; ++n) { const f32x4 b = *(const f32x4*)(base + off + bj * HALF + n * 16); const f32x4 v = b + acc[ai][bj][m][n] * f;
                        u32x2 w; w.x = cvt_pk_bf16(v[0], v[1]); w.y = cvt_pk_bf16(v[2], v[3]); *(u32x2*)(out + off + bj * HALF + n * 16) = w; } } }
    __device__ __forceinline__ void operator()(const f32x4 (&)[2][2][4][2], const Unit&, int, int, int, int) const {}
};
__device__ __forceinline__ float sgpr_f(unsigned bits) { return __builtin_bit_cast(float, __builtin_amdgcn_readfirstlane((int)bits)); }
__device__ __forceinline__ float swiglu1(float g, float u) { const float c7 = sgpr_f(0x40e00000u); g = fminf(g, c7); u = fminf(fmaxf(u, -c7), c7); const float s = __builtin_amdgcn_rcpf(1.f + __builtin_amdgcn_exp2f(g * (-1.702f * 1.4426950408889634f))); return g * s * (u + 1.f); }
__device__ __forceinline__ unsigned cvt4_fp8(float a, float b, float c, float d) {
    const float mx = __builtin_bit_cast(float, __builtin_amdgcn_readfirstlane(0x43e00000)); a = fminf(fmaxf(a, -mx), mx); b = fminf(fmaxf(b, -mx), mx); c = fminf(fmaxf(c, -mx), mx); d = fminf(fmaxf(d, -mx), mx);
    int w = 0; w = __builtin_amdgcn_cvt_pk_fp8_f32(a, b, w, false); w = __builtin_amdgcn_cvt_pk_fp8_f32(c, d, w, true); return (unsigned)w; }
struct EpiSwiglu { static constexpr bool PERM = true, AFTER_DRAIN = false, MIDK = false; unsigned char* ACT; const float* bias; float sc_in, sc_out;
    __device__ __forceinline__ void operator()(const f32x4 (&acc)[2][2][4][2], const Unit& u, int wr, int wc, int fr, int fq) const {
        const int e = u.pn >> 3, pn = u.pn & 7; const int colg = pn * BM + wc * 32 + 8 * fq; const int row0 = u.pm * BM + wr * 64 + fr;
        f32x4 bv[2][2];
#pragma unroll
        for (int bj = 0; bj < 2; ++bj)
#pragma unroll
            for (int n = 0; n < 2; ++n) bv[bj][n] = *(const f32x4*)(bias + (size_t)e * 2048 + colg + bj * HALF + 4 * n);
#pragma unroll
        for (int ai = 0; ai < 2; ++ai)
#pragma unroll
            for (int m = 0; m < 4; ++m) { unsigned char* rowp = ACT + (size_t)(row0 + ai * HALF + m * 16) * 1024 + (colg >> 1);
#pragma unroll
                for (int bj = 0; bj < 2; ++bj) { const f32x4 v0 = acc[ai][bj][m][0] * sc_in + bv[bj][0], v1 = acc[ai][bj][m][1] * sc_in + bv[bj][1];
                    *(unsigned*)(rowp + bj * (HALF / 2)) = cvt4_fp8(swiglu1(v0[0], v0[1]) * sc_out, swiglu1(v0[2], v0[3]) * sc_out, swiglu1(v1[0], v1[1]) * sc_out, swiglu1(v1[2], v1[3]) * sc_out); } }
    } };
struct EpiDownG { static constexpr bool PERM = true, AFTER_DRAIN = false, MIDK = false; unsigned char* Y; const float* bias; const float* gs; const int* rowdst; float sc_in, sc_out;
    __device__ __forceinline__ void operator()(const f32x4 (&acc)[2][2][4][2], const Unit& u, int wr, int wc, int fr, int fq) const {
        const int e = u.pn >> 2, pn = u.pn & 3; const int col = pn * BM + wc * 32 + 8 * fq; const int row0 = u.pm * BM + wr * 64 + fr;
        f32x4 bv[2][2];
#pragma unroll
        for (int bj = 0; bj < 2; ++bj)
#pragma unroll
            for (int n = 0; n < 2; ++n) bv[bj][n] = *(const f32x4*)(bias + (size_t)e * 1024 + col + bj * HALF + 4 * n);
#pragma unroll
        for (int ai = 0; ai < 2; ++ai)
#pragma unroll
            for (int m = 0; m < 4; ++m) { const int row = row0 + ai * HALF + m * 16; const float g = gs[row] * sc_out; const int dst = rowdst[row];
                if (dst >= 0) { unsigned char* rowp = Y + (size_t)dst * 1024 + col;
#pragma unroll
                    for (int bj = 0; bj < 2; ++bj) { const f32x4 v0 = (acc[ai][bj][m][0] * sc_in + bv[bj][0]) * g, v1 = (acc[ai][bj][m][1] * sc_in + bv[bj][1]) * g;
                        typedef unsigned u32x2v __attribute__((ext_vector_type(2))); u32x2v w; w.x = cvt4_fp8(v0[0], v0[1], v0[2], v0[3]); w.y = cvt4_fp8(v1[0], v1[1], v1[2], v1[3]);
                        *(u32x2v*)(rowp + bj * HALF) = w; } } }
    } };
struct EpiQKV { static constexpr bool PERM = true, AFTER_DRAIN = false, MIDK = false; bf16_t* O; size_t split_stride; float scale0; unsigned* kn2;
    __device__ __forceinline__ void operator()(const f32x4 (&acc)[2][2][4][2], const Unit& u, int wr, int wc, int fr, int fq) const {
        const int row0 = u.pm * BM + wr * 64 + fr; int colt = u.pn * BM; const int t = colt / 1024; bf16_t* base = O + (size_t)t * split_stride; colt -= t * 1024; const float sc = (t == 0) ? scale0 : 1.f;
        const int col0 = colt + wc * 32 + 8 * fq;
        float mx[2] = {0.f, 0.f};
#pragma unroll
        for (int ai = 0; ai < 2; ++ai)
#pragma unroll
            for (int m = 0; m < 4; ++m) { bf16_t* rowp = base + (size_t)(row0 + ai * HALF + m * 16) * 1024 + col0;
#pragma unroll
                for (int bj = 0; bj < 2; ++bj) { const f32x4 v0 = acc[ai][bj][m][0] * sc, v1 = acc[ai][bj][m][1] * sc;
                    u32x4 w; w.x = cvt_pk_bf16(v0[0], v0[1]); w.y = cvt_pk_bf16(v0[2], v0[3]); w.z = cvt_pk_bf16(v1[0], v1[1]); w.w = cvt_pk_bf16(v1[2], v1[3]);
                    *(u32x4*)(rowp + bj * HALF) = w;
                    if (t == 1) { float s = (v0[0] * v0[0] + v0[1] * v0[1]) + (v0[2] * v0[2] + v0[3] * v0[3]) + (v1[0] * v1[0] + v1[1] * v1[1]) + (v1[2] * v1[2] + v1[3] * v1[3]);
                        s += __shfl_xor(s, 16); s += __shfl_xor(s, 32); mx[bj] = fmaxf(mx[bj], s); } } }
        if (t == 1) {
#pragma unroll
            for (int bj = 0; bj < 2; ++bj) { float m = mx[bj]; m = fmaxf(m, __shfl_xor(m, 1)); m = fmaxf(m, __shfl_xor(m, 2)); m = fmaxf(m, __shfl_xor(m, 4)); m = fmaxf(m, __shfl_xor(m, 8));
                if (fr == 0 && fq == 0) atomicMax(kn2 + ((u.pm >> 5) * 16 + (colt + bj * HALF) / 64 + (wc >> 1)) * 2 + (wc & 1), __float_as_uint(m)); } }
    } };
struct GroupedOrder {
    const int* tile_e; int nN, nwg, G, c;
    __device__ void init(const int* TILE, int nN_, int G_, int c_) { const int nt = __builtin_amdgcn_readfirstlane(TILE[0]); tile_e = TILE + 16; nN = nN_; nwg = nt * nN_; G = G_; c = c_; }
    __device__ bool next(int i, Unit& u) const {
        const int L = i * G + c; if (L >= nwg) return false;
        int wgid = L; { const int q = nwg / NXCD, r = nwg % NXCD, xcd = wgid % NXCD, off = wgid / NXCD; wgid = (xcd < r ? xcd * (q + 1) : r * (q + 1) + (xcd - r) * q) + off; }
        const int pm = wgid / nN, pn = wgid % nN; const int e = __builtin_amdgcn_readfirstlane(tile_e[pm]);
        u.pm = pm; u.pn = e * nN + pn; return true;
    }
    __device__ __forceinline__ void a_ready(const Unit&) const {}
    __device__ __forceinline__ void done(const Unit&) const {}
};
template <class Epi, class Sched, bool ALIGN_EPI = false, bool SP2 = false, bool GATHER = false, bool FP8 = false>
__device__ __forceinline__ void gemm_phase(PG8_LAS unsigned char* lds, const Gemm g, const Sched& S, const Epi& E, const int* rowtok = nullptr) {
    static_assert(!GATHER || SP2, "GATHER is written for the SP2 loop");
    const int tid = threadIdx.x, wid = __builtin_amdgcn_readfirstlane(tid >> 6), lane = tid & 63, wr = wid >> 2, wc = wid & 3, fr = lane & 15, fq = lane >> 4;
    const int K = g.K, nt = K / BK;
    unsigned voffA[2], voffB[2]; unsigned vA[2][2], nvA[2][2];
#pragma unroll
    for (int i = 0; i < 2; ++i) { int R, C; stage_rc(tid * 16 + i * 8192, R, C); const int Rb = Epi::PERM ? ((R & ~31) + perm32(R & 31)) : R;
        voffA[i] = (unsigned)(R * K + C) * 2u; voffB[i] = (unsigned)(Rb * K + C) * 2u; }
    const unsigned kstep = (unsigned)(BK * 2);
    const unsigned hstep = (unsigned)HALF * K * 2;
    const unsigned tstep = 2 * hstep, r64step = 64u * (unsigned)K * 2u;
    const __amdgpu_buffer_rsrc_t rsA = __builtin_amdgcn_make_buffer_rsrc((void*)g.A, 0, 0x7fffffff, 0x00020000), rsB = __builtin_amdgcn_make_buffer_rsrc((void*)g.Bt, 0, 0x7fffffff, 0x00020000);
    const unsigned ldsw = (unsigned)wid * 1024u;
    const int aoff = lds_byte(wr * 64 + fr, fq * 8), boff = lds_byte(wc * 32 + fr, fq * 8);
#define PG8_SA(b, h) (((b) * 2 + (h)) * HTB)
#define PG8_SB(b, h) ((4 + (b) * 2 + (h)) * HTB)
#define PG8_STAGE_R(rs, bufoff, soff, voff) do { _Pragma("unroll") for (int _i = 0; _i < 2; ++_i)     \
        __builtin_amdgcn_raw_ptr_buffer_load_lds(rs, (PG8_LAS unsigned*)(lds + (bufoff) + ldsw + _i * 8192), 16, (int)(voff)[0], (int)((soff) + _i * r64step), 0, 0); } while (0)
#define PG8_STAGE2(bufoff, soff, v0, v1) do { __builtin_amdgcn_raw_ptr_buffer_load_lds(rsA, (PG8_LAS unsigned*)(lds + (bufoff) + ldsw), 16, (int)(v0), (int)(soff), 0, 0); \
        __builtin_amdgcn_raw_ptr_buffer_load_lds(rsA, (PG8_LAS unsigned*)(lds + (bufoff) + ldsw + 8192), 16, (int)(v1), (int)(soff), 0, 0); } while (0)
#define PG8_STAGE_A(bufoff, h, gbase, nx) do { if constexpr (GATHER) { const unsigned s0_ = (nx) ? nvA[h][0] : vA[h][0], s1_ = (nx) ? nvA[h][1] : vA[h][1]; PG8_STAGE2(bufoff, gbase, s0_, s1_); } \
        else { PG8_STAGE_R(rsA, bufoff, (gbase) + ((h) ? hstep : 0u), voffA); } } while (0)
#define PG8_GATHER_OFFS(dst, un) do { _Pragma("unroll") for (int h_ = 0; h_ < 2; ++h_) _Pragma("unroll") for (int i_ = 0; i_ < 2; ++i_) \
        { int R_, C_; stage_rc(tid * 16 + i_ * 8192, R_, C_); dst[h_][i_] = (unsigned)rowtok[(un).pm * BM + h_ * HALF + R_] * (unsigned)(K * 2) + (unsigned)C_ * 2u; } } while (0)
#define PG8_LDA(dst, b, h) do { _Pragma("unroll") for (int m = 0; m < 4; ++m) _Pragma("unroll") for (int k = 0; k < 2; ++k) dst[m][k] = *(const PG8_LAS bf16x8*)(lds + PG8_SA(b, h) + aoff + m * 2048 + k * 1024); } while (0)
#define PG8_LDB(dst, b, h) do { _Pragma("unroll") for (int n = 0; n < 2; ++n) _Pragma("unroll") for (int k = 0; k < 2; ++k) dst[n][k] = *(const PG8_LAS bf16x8*)(lds + PG8_SB(b, h) + boff + n * 2048 + k * 1024); } while (0)
#define PG8_CAT8(x) __builtin_shufflevector(__builtin_bit_cast(i32x4_t, (x)[0]), __builtin_bit_cast(i32x4_t, (x)[1]), 0, 1, 2, 3, 4, 5, 6, 7)
#define PG8_MMA(ai, bj, At, Bt) do { __builtin_amdgcn_s_setprio(1); _Pragma("unroll") for (int m = 0; m < 4; ++m) _Pragma("unroll") for (int n = 0; n < 2; ++n) { \
        if constexpr (FP8) { acc[ai][bj][m][n] = __builtin_amdgcn_mfma_scale_f32_16x16x128_f8f6f4(PG8_CAT8(Bt[n]), PG8_CAT8(At[m]), acc[ai][bj][m][n], 0, 0, 0, 0, 0, 0); } \
        else { _Pragma("unroll") for (int k = 0; k < 2; ++k) acc[ai][bj][m][n] = __builtin_amdgcn_mfma_f32_16x16x32_bf16(Bt[n][k], At[m][k], acc[ai][bj][m][n], 0, 0, 0); } } \
        __builtin_amdgcn_s_setprio(0); } while (0)
#define PG8_WAIT_V(n) asm volatile("s_waitcnt vmcnt(" #n ")" ::: "memory")
#define PG8_WAIT_L(n) asm volatile("s_waitcnt lgkmcnt(" #n ")" ::: "memory")
#define PG8_BAR __builtin_amdgcn_s_barrier()
#define PG8_SCHED __builtin_amdgcn_sched_barrier(0)
    Unit cur, nxt; int ui = 0;
    if (!S.next(0, cur)) return;
    if constexpr (Epi::MIDK) E.prep(cur, 0, tid);
    f32x4 acc[2][2][4][2];
#pragma unroll
    for (int a = 0; a < 2; ++a)
#pragma unroll
        for (int b = 0; b < 2; ++b)
#pragma unroll
            for (int m = 0; m < 4; ++m)
#pragma unroll
                for (int n = 0; n < 2; ++n) { acc[a][b][m][n] = (f32x4){0.f, 0.f, 0.f, 0.f}; if constexpr (FP8) asm volatile("" : "+v"(acc[a][b][m][n])); }
    bf16x8 At[4][2], B0[2][2], B1[2][2];
    unsigned cA = GATHER ? 0u : (unsigned)cur.pm * tstep; unsigned cB = (unsigned)cur.pn * tstep;
    if constexpr (GATHER) { PG8_GATHER_OFFS(vA, cur); }
    S.a_ready(cur);
    if constexpr (SP2) {
        PG8_STAGE_R(rsB, PG8_SB(0, 0), cB, voffB); PG8_STAGE_R(rsB, PG8_SB(0, 1), cB + hstep, voffB); PG8_STAGE_A(PG8_SA(0, 0), 0, cA, false); PG8_STAGE_A(PG8_SA(0, 1), 1, cA, false);
        if (wr == 1) PG8_BAR;
        PG8_WAIT_V(2); PG8_BAR;
        PG8_STAGE_R(rsB, PG8_SB(1, 0), cB + kstep, voffB); PG8_STAGE_A(PG8_SA(1, 0), 0, cA + kstep, false); PG8_STAGE_R(rsB, PG8_SB(1, 1), cB + hstep + kstep, voffB);
        PG8_WAIT_V(6); PG8_BAR;
    } else {
        PG8_STAGE_R(rsB, PG8_SB(0, 0), cB, voffB); PG8_STAGE_R(rsA, PG8_SA(0, 0), cA, voffA); PG8_STAGE_R(rsB, PG8_SB(0, 1), cB + hstep, voffB); PG8_STAGE_R(rsA, PG8_SA(0, 1), cA + hstep, voffA);
        if (wr == 1) PG8_BAR;
        PG8_WAIT_V(4); PG8_BAR;
        PG8_STAGE_R(rsB, PG8_SB(1, 0), cB + kstep, voffB); PG8_STAGE_R(rsA, PG8_SA(1, 0), cA + kstep, voffA); PG8_STAGE_R(rsB, PG8_SB(1, 1), cB + hstep + kstep, voffB);
        PG8_WAIT_V(6); PG8_BAR;
    }
    for (;;) {
        const bool has_next = S.next(ui + 1, nxt);
        if constexpr (Epi::MIDK) { if (has_next) E.prep(nxt, (ui + 1) & 1, tid); }
        if constexpr (GATHER) { if (has_next) { PG8_GATHER_OFFS(nvA, nxt); } else { _Pragma("unroll") for (int h_ = 0; h_ < 2; ++h_) _Pragma("unroll") for (int i_ = 0; i_ < 2; ++i_) nvA[h_][i_] = vA[h_][i_]; } }
        const unsigned nA = GATHER ? 0u : (has_next ? (unsigned)nxt.pm * tstep : cA); const unsigned nB = has_next ? (unsigned)nxt.pn * tstep : cB;
        for (int t = 0; t < nt; t += 2) {
            const bool last = (t == nt - 2);
            const unsigned a1 = cA + (unsigned)(t + 1) * kstep;
            const unsigned a2 = last ? nA : cA + (unsigned)(t + 2) * kstep; const unsigned b2 = last ? nB : cB + (unsigned)(t + 2) * kstep;
            const unsigned a3 = a2 + kstep; const unsigned b3 = b2 + kstep;
            if (last && has_next) S.a_ready(nxt);
            if constexpr (SP2) {
            PG8_LDB(B0, 0, 0); PG8_LDB(B1, 0, 1); PG8_SCHED; PG8_LDA(At, 0, 0); PG8_STAGE_A(PG8_SA(1, 1), 1, a1, false);
            PG8_WAIT_V(8); PG8_WAIT_L(0); PG8_BAR; PG8_MMA(0, 0, At, B0); PG8_MMA(0, 1, At, B1); PG8_BAR; PG8_SCHED;
            PG8_LDA(At, 0, 1); PG8_STAGE_R(rsB, PG8_SB(0, 0), b2, voffB); PG8_STAGE_R(rsB, PG8_SB(0, 1), b2 + hstep, voffB); PG8_STAGE_A(PG8_SA(0, 0), 0, a2, last);
            PG8_WAIT_V(8); PG8_WAIT_L(0); PG8_BAR; PG8_MMA(1, 0, At, B0); PG8_MMA(1, 1, At, B1); PG8_BAR; PG8_SCHED;
            PG8_LDB(B0, 1, 0); PG8_LDB(B1, 1, 1); PG8_SCHED; PG8_LDA(At, 1, 0); PG8_STAGE_A(PG8_SA(0, 1), 1, a2, last);
            PG8_WAIT_V(8); PG8_WAIT_L(0); PG8_BAR; PG8_MMA(0, 0, At, B0); PG8_MMA(0, 1, At, B1); PG8_BAR; PG8_SCHED;
            PG8_LDA(At, 1, 1); PG8_STAGE_R(rsB, PG8_SB(1, 0), b3, voffB); PG8_STAGE_R(rsB, PG8_SB(1, 1), b3 + hstep, voffB); PG8_STAGE_A(PG8_SA(1, 0), 0, a3, last);
            PG8_WAIT_V(8); PG8_WAIT_L(0); PG8_BAR; PG8_MMA(1, 0, At, B0); PG8_MMA(1, 1, At, B1); PG8_BAR; PG8_SCHED;
            } else {
            PG8_LDB(B0, 0, 0); PG8_SCHED; PG8_LDA(At, 0, 0); PG8_STAGE_R(rsA, PG8_SA(1, 1), a1 + hstep, voffA);
            PG8_WAIT_L(8); PG8_BAR; PG8_WAIT_L(0); PG8_MMA(0, 0, At, B0); PG8_BAR; PG8_SCHED;
            PG8_LDB(B1, 0, 1); PG8_STAGE_R(rsB, PG8_SB(0, 0), b2, voffB);
            PG8_BAR; PG8_WAIT_L(0); PG8_MMA(0, 1, At, B1); PG8_BAR;
            PG8_LDA(At, 0, 1); PG8_STAGE_R(rsA, PG8_SA(0, 0), a2, voffA);
            PG8_BAR; PG8_WAIT_L(0); PG8_MMA(1, 0, At, B0); PG8_BAR; PG8_SCHED;
            PG8_STAGE_R(rsB, PG8_SB(0, 1), b2 + hstep, voffB);
            PG8_WAIT_V(6); PG8_BAR; PG8_MMA(1, 1, At, B1); PG8_BAR;
            PG8_LDB(B0, 1, 0); PG8_SCHED; PG8_LDA(At, 1, 0); PG8_STAGE_R(rsA, PG8_SA(0, 1), a2 + hstep, voffA);
            PG8_WAIT_L(8); PG8_BAR; PG8_WAIT_L(0); PG8_MMA(0, 0, At, B0); PG8_BAR; PG8_SCHED;
            PG8_LDB(B1, 1, 1); PG8_STAGE_R(rsB, PG8_SB(1, 0), b3, voffB);
            PG8_BAR; PG8_WAIT_L(0); PG8_MMA(0, 1, At, B1); PG8_BAR;
            PG8_LDA(At, 1, 1); PG8_STAGE_R(rsA, PG8_SA(1, 0), a3, voffA);
            PG8_BAR; PG8_WAIT_L(0); PG8_MMA(1, 0, At, B0); PG8_BAR; PG8_SCHED;
            PG8_STAGE_R(rsB, PG8_SB(1, 1), b3 + hstep, voffB);
            PG8_WAIT_V(6); PG8_BAR; PG8_MMA(1, 1, At, B1); PG8_BAR;
            }
            if constexpr (Epi::MIDK) { if (t == nt / 2 - 2) E.midk(acc, ui & 1, wr, fr); }
        }
        if constexpr (ALIGN_EPI) { if (wr == 0) PG8_BAR; }
        int l_e; asm volatile("v_mbcnt_lo_u32_b32 %0, -1, 0\n\tv_mbcnt_hi_u32_b32 %0, -1, %0" : "=v"(l_e)); const int fr_e = l_e & 15, fq_e = l_e >> 4;
        if constexpr (Epi::MIDK) { E.epi(acc, cur, ui & 1, wr, wc, fr_e, fq_e); S.done(cur); }
        else if constexpr (!Epi::AFTER_DRAIN) { E(acc, cur, wr, wc, fr_e, fq_e); S.done(cur); }
        if (!has_next) break;
#pragma unroll
        for (int a = 0; a < 2; ++a)
#pragma unroll
            for (int b = 0; b < 2; ++b)
#pragma unroll
                for (int m = 0; m < 4; ++m)
#pragma unroll
                    for (int n = 0; n < 2; ++n) { acc[a][b][m][n] = (f32x4){0.f, 0.f, 0.f, 0.f}; if constexpr (FP8) asm volatile("" : "+v"(acc[a][b][m][n])); }
        cur = nxt; cA = nA; cB = nB; ++ui;
        if constexpr (GATHER) { _Pragma("unroll") for (int h_ = 0; h_ < 2; ++h_) _Pragma("unroll") for (int i_ = 0; i_ < 2; ++i_) vA[h_][i_] = nvA[h_][i_]; }
        if constexpr (ALIGN_EPI) { if (wr == 1) PG8_BAR; }
    }
    PG8_WAIT_V(0);
    if constexpr (!ALIGN_EPI) { if (wr == 0) PG8_BAR; }
    PG8_BAR;
    if constexpr (Epi::AFTER_DRAIN) { E.fused(acc, cur, wr, wc, fr, fq, lds, wid, lane); S.done(cur); }
#undef PG8_SA
#undef PG8_SB
#undef PG8_STAGE_R
#undef PG8_STAGE2
#undef PG8_STAGE_A
#undef PG8_GATHER_OFFS
#undef PG8_LDA
#undef PG8_LDB
#undef PG8_MMA
#undef PG8_CAT8
#undef PG8_WAIT_V
#undef PG8_WAIT_L
#undef PG8_BAR
#undef PG8_SCHED
}
}

namespace att {
typedef short bf16x8 __attribute__((ext_vector_type(8)));
typedef short s16x4 __attribute__((ext_vector_type(4)));
typedef float f32x16 __attribute__((ext_vector_type(16)));
typedef float f32x4 __attribute__((ext_vector_type(4)));
typedef unsigned u32x4 __attribute__((ext_vector_type(4)));
typedef unsigned u32x2 __attribute__((ext_vector_type(2)));
typedef short v4i16_t __attribute__((ext_vector_type(4)));
typedef __attribute__((address_space(3))) const char* lds_cptr;
constexpr int DM = 1024, SLOTB = 8192;
constexpr int NSLOT = 8, DIST = 4;
constexpr int L_K = 0, L_V = NSLOT * SLOTB, L_B = 2 * NSLOT * SLOTB, L_DONE = L_B + NSLOT * 256, L_BYTES = L_DONE + 64;
constexpr float FOX_THR = 40.f, SB_THR = 32.f;
__device__ __forceinline__ int crow(int r, int hi) { return (r & 3) + 8 * (r >> 2) + 4 * hi; }
__device__ __forceinline__ void glds16(const void* gsrc, unsigned lds_dst) { unsigned keep;
    asm volatile("s_mov_b32 %0, m0\n\ts_mov_b32 m0, %2\n\ts_nop 0\n\tglobal_load_lds_dwordx4 %1, off\n\ts_mov_b32 m0, %0" : "=&s"(keep) : "v"(gsrc), "s"(lds_dst) : "memory"); }
__device__ __forceinline__ void glds4(const void* gsrc, unsigned lds_dst) { unsigned keep;
    asm volatile("s_mov_b32 %0, m0\n\ts_mov_b32 m0, %2\n\ts_nop 0\n\tglobal_load_lds_dword %1, off\n\ts_mov_b32 m0, %0" : "=&s"(keep) : "v"(gsrc), "s"(lds_dst) : "memory"); }
typedef float f32x2_t __attribute__((ext_vector_type(2))); typedef __bf16 bf16x2_t __attribute__((ext_vector_type(2)));
__device__ __forceinline__ unsigned cvtpk(float lo, float hi) { f32x2_t v = {lo, hi}; bf16x2_t b = __builtin_convertvector(v, bf16x2_t); return __builtin_bit_cast(unsigned, b); }
__device__ __forceinline__ s16x4 vtr(lds_cptr p) { return __builtin_bit_cast(s16x4, __builtin_amdgcn_ds_read_tr16_b64_v4i16((__attribute__((address_space(3))) v4i16_t*)p)); }
#define ATT_WAIT_BAR() asm volatile("s_waitcnt vmcnt(0) lgkmcnt(0)\n\ts_barrier" ::: "memory")
#define ATT_BAR() asm volatile("s_barrier" ::: "memory")
#define ATT_LBAR() asm volatile("s_waitcnt lgkmcnt(0)\n\ts_barrier" ::: "memory")
#define ATT_WAITV_BAR(n) asm volatile("s_waitcnt vmcnt(" #n ") lgkmcnt(0)\n\ts_barrier" ::: "memory")
__device__ __forceinline__ float max3f(float a, float b, float c) { float r; asm("v_max3_f32 %0, %1, %2, %3" : "=v"(r) : "v"(a), "v"(b), "v"(c)); return r; }

constexpr int G_SLOTS = 4;
constexpr int G_K = 0, G_V = G_SLOTS * SLOTB, G_B = 2 * G_SLOTS * SLOTB, G_DONE = G_B + G_SLOTS * 256, G_ARR = G_DONE + 64, G_BYTES = G_ARR + 64;
typedef volatile __attribute__((address_space(3))) unsigned* lds_vu32;
__device__ __forceinline__ void grp_barrier(lds_vu32 arr, unsigned& epoch, int wid, int lane) {
    ++epoch;
    if (lane == 0) arr[wid] = epoch;
    for (;;) { const unsigned v = (lane < 4) ? arr[lane] : epoch; if (__all(v >= epoch)) break; __builtin_amdgcn_s_sleep(0); }
    asm volatile("" ::: "memory");
}
#define G_WAITV(n) asm volatile("s_waitcnt vmcnt(" #n ") lgkmcnt(0)" ::: "memory")
template <bool FOX, bool PRUNE>
__device__ __forceinline__ void attn_unit4(int b, int h16, int qb, const bf16* QO, bf16* F_O, const bf16* __restrict__ K, const bf16* __restrict__ V, float* SSQ, const float* CLrow, float KN, char* shm, unsigned& epoch) {
    const int tid = threadIdx.x, lane = tid & 63, r32 = lane & 31, hi = lane >> 5; const int wid = __builtin_amdgcn_readfirstlane((tid >> 6) & 3);
    const long rowbase = (long)b * SEQ; const int q0 = qb * 128;
    const bf16* Qw = QO + (rowbase + q0 + wid * 32) * DM + h16 * 64;
    const bf16* Kh = K + rowbase * DM + h16 * 64; const bf16* Vh = V + rowbase * DM + h16 * 64;
    const unsigned lds0 = (unsigned)(uintptr_t)shm;
    const bf16* ksrc = Kh + (long)(8 * wid + (lane >> 3)) * DM + (((lane & 7) ^ (lane >> 3)) * 8);
    const bf16* vsrc = Vh + (long)(16 * wid + (lane >> 2)) * DM + (lane & 3) * 8;
    const unsigned kdst = lds0 + G_K + wid * 1024, vdst = lds0 + G_V + wid * 1024, bdst = lds0 + G_B;
    const lds_cptr shm3 = (lds_cptr)shm;
    const lds_cptr kp0 = shm3 + G_K + r32 * 128; const int kx = ((r32 & 7) ^ hi) << 4;
    const lds_cptr vp0 = shm3 + G_V + ((lane >> 4) & 1) * 32 + (lane & 3) * 8 + (4 * hi + ((lane & 15) >> 2)) * 64;
    volatile __attribute__((address_space(3))) int* done_at = (volatile __attribute__((address_space(3))) int*)(shm3 + G_DONE);
    lds_vu32 arr = (lds_vu32)(shm3 + G_ARR);
    const int NT = (q0 + 128) / 64;
#define G_DMA(t, slot) do { glds16(ksrc + (long)(t) * 64 * DM, (unsigned)__builtin_amdgcn_readfirstlane(kdst + (slot) * SLOTB)); glds16(ksrc + (long)((t) * 64 + 32) * DM, (unsigned)__builtin_amdgcn_readfirstlane(kdst + 4096 + (slot) * SLOTB)); \
        glds16(vsrc + (long)(t) * 64 * DM, (unsigned)__builtin_amdgcn_readfirstlane(vdst + (slot) * SLOTB)); glds16(vsrc + (long)(t) * 64 * DM + 32, (unsigned)__builtin_amdgcn_readfirstlane(vdst + 4096 + (slot) * SLOTB)); \
        if (FOX) glds4(CLrow + (t) * 64 + lane, (unsigned)__builtin_amdgcn_readfirstlane(bdst + (slot) * 256)); } while (0)
    bf16x8 qr[4];
#pragma unroll
    for (int d0 = 0; d0 < 4; ++d0) qr[d0] = *reinterpret_cast<const bf16x8*>(&Qw[(long)r32 * DM + d0 * 16 + hi * 8]);
    float qn = 0.f;
    if (FOX && PRUNE) {
#pragma unroll
        for (int d0 = 0; d0 < 4; ++d0)
#pragma unroll
            for (int j = 0; j < 8; ++j) { const float v = __builtin_bit_cast(float, (unsigned)(unsigned short)qr[d0][j] << 16); qn += v * v; }
        qn += __shfl_xor(qn, 32); qn = sqrtf(qn) * KN;
    }
    const float clref = FOX ? CLrow[q0 + wid * 32] : 0.f;
    const int qrel = wid * 32 + r32;
    asm volatile("" :: "v"(qr[0]), "v"(qr[1]), "v"(qr[2]), "v"(qr[3]), "v"(clref), "v"(qn));
    G_WAITV(0); grp_barrier(arr, epoch, wid, lane);
    if (lane == 0) done_at[wid] = 0x7fffffff;
    G_DMA(NT - 1, 0); G_DMA(NT - 2, 1); if (NT >= 3) G_DMA(NT - 3, 2);
    f32x16 o0 = {}, o1 = {}, lacc = {};
    float mref = 0.f, R = 0.f;
    bool mydone = false, posted = false, first = true;
    bf16x8 U0, U1, ONES;
#pragma unroll
    for (int j = 0; j < 8; ++j) { const int kk = 8 * (j >> 2) + 4 * hi + (j & 3); U0[j] = (kk > r32) ? (short)0x3f80 : (short)0; U1[j] = (16 + kk > r32) ? (short)0x3f80 : (short)0; ONES[j] = (short)0x3f80; }
    for (int i = 0;; ++i) {
        const int t = NT - 1 - i, slot = i & (G_SLOTS - 1);
        if (t < 0) break;
        { const int ahead = t < 2 ? t : 2;
          if (FOX) { if (ahead == 2) G_WAITV(10); else if (ahead == 1) G_WAITV(5); else G_WAITV(0); }
          else     { if (ahead == 2) G_WAITV(8); else if (ahead == 1) G_WAITV(4); else G_WAITV(0); } }
        grp_barrier(arr, epoch, wid, lane);
        if (i > 0) { const int da = done_at[lane & 3]; if (__all(da <= i - 1)) break; }
        if (t >= 3) G_DMA(t - 3, (i + 3) & (G_SLOTS - 1));
        const int jb = t - (NT - 2);
        if (!mydone && !(jb >= 0 && 2 * jb > wid)) {
            const lds_cptr kp = kp0 + slot * SLOTB; const lds_cptr vp = vp0 + slot * SLOTB;
            bf16x8 kf[8];
#pragma unroll
            for (int d0 = 0; d0 < 4; ++d0) { const int ko = kx ^ (d0 << 5); kf[2 * d0] = *(const __attribute__((address_space(3))) bf16x8*)(kp + ko); kf[2 * d0 + 1] = *(const __attribute__((address_space(3))) bf16x8*)(kp + ko + 4096); }
            const bool need_mask = __builtin_amdgcn_readfirstlane((int)(jb >= 0 && 64 * jb + 63 > 32 * wid)) != 0;
            f32x16 p0, p1; float bias00 = 0.f;
            if (FOX) {
                const __attribute__((address_space(3))) f32x4* bp = (const __attribute__((address_space(3))) f32x4*)(shm3 + G_B + slot * 256);
                const float cm = clref - mref;
#pragma unroll
                for (int g = 0; g < 4; ++g) { const f32x4 c0 = bp[2 * g + hi], c1 = bp[8 + 2 * g + hi];
#pragma unroll
                    for (int e = 0; e < 4; ++e) { p0[4 * g + e] = cm - c0[e]; p1[4 * g + e] = cm - c1[e]; } }
                bias00 = clref - bp[0][0];
            } else { p0 = f32x16{}; p1 = f32x16{}; }
#pragma unroll
            for (int d0 = 0; d0 < 4; ++d0) { p0 = __builtin_amdgcn_mfma_f32_32x32x16_bf16(kf[2 * d0], qr[d0], p0, 0, 0, 0); p1 = __builtin_amdgcn_mfma_f32_32x32x16_bf16(kf[2 * d0 + 1], qr[d0], p1, 0, 0, 0); }
            s16x4 vlo[8], vhi[8];
#pragma unroll
            for (int q = 0; q < 8; ++q) { vlo[q] = vtr(vp + ((q >> 2) * 4096 + (q & 3) * 1024)); vhi[q] = vtr(vp + ((q >> 2) * 4096 + (q & 3) * 1024 + 512)); }
            if (FOX) asm volatile("s_nop 15\n\ts_nop 7" : "+v"(p0), "+v"(p1));
            if (FOX) {
                if (need_mask) { asm volatile("" ::: "memory");
#pragma unroll
                    for (int r = 0; r < 16; ++r) { const int kv = 64 * jb + crow(r, hi); if (kv > qrel) p0[r] = -INFINITY; if (kv + 32 > qrel) p1[r] = -INFINITY; } }
                float ma = max3f(p0[0], p1[0], p0[1]), mb = max3f(p1[1], p0[2], p1[2]);
#pragma unroll
                for (int r = 3; r < 15; r += 2) { ma = max3f(ma, p0[r], p1[r]); mb = max3f(mb, p0[r + 1], p1[r + 1]); }
                ma = max3f(ma, p0[15], p1[15]);
                float mt = max3f(ma, mb, mb); mt = max3f(mt, __shfl_xor(mt, 32), mt);
                if (first || __any(mt > 0.f)) {
                    const float d = first ? mt : fmaxf(mt, 0.f); mref += d;
                    if (!first) { const float alpha = __builtin_amdgcn_exp2f(-d);
#pragma unroll
                        for (int r = 0; r < 16; ++r) { o0[r] *= alpha; o1[r] *= alpha; }
                        lacc[0] *= alpha; }
#pragma unroll
                    for (int r = 0; r < 16; ++r) { p0[r] -= d; p1[r] -= d; }
                    first = false;
                }
#pragma unroll
                for (int r = 0; r < 16; ++r) { p0[r] = __builtin_amdgcn_exp2f(p0[r]); p1[r] = __builtin_amdgcn_exp2f(p1[r]); }
                if (t == 0) mydone = true;
                else if (PRUNE) mydone = __all(qn + bias00 - mref < -FOX_THR);
            } else {
                f32x16 x0, x1;
#pragma unroll
                for (int r = 0; r < 16; ++r) {
                    { const float z = p0[r]; const float sp = __builtin_amdgcn_logf(1.f + __builtin_amdgcn_exp2f(-fabsf(z))); const float lb = fminf(z, 0.f) - sp; p0[r] = lb; x0[r] = lb - z; }
                    { const float z = p1[r]; const float sp = __builtin_amdgcn_logf(1.f + __builtin_amdgcn_exp2f(-fabsf(z))); const float lb = fminf(z, 0.f) - sp; p1[r] = lb; x1[r] = lb - z; } }
                if (need_mask) { asm volatile("" ::: "memory");
#pragma unroll
                    for (int r = 0; r < 16; ++r) { const int kv = 64 * jb + crow(r, hi); if (kv >= qrel) { p0[r] = -INFINITY; x0[r] = 0.f; } if (kv + 32 >= qrel) { p1[r] = -INFINITY; x1[r] = 0.f; } } }
                u32x4 xw0, xw1, xw2, xw3;
                xw0 = (u32x4){cvtpk(x0[0], x0[1]), cvtpk(x0[2], x0[3]), cvtpk(x0[4], x0[5]), cvtpk(x0[6], x0[7])}; xw1 = (u32x4){cvtpk(x0[8], x0[9]), cvtpk(x0[10], x0[11]), cvtpk(x0[12], x0[13]), cvtpk(x0[14], x0[15])};
                xw2 = (u32x4){cvtpk(x1[0], x1[1]), cvtpk(x1[2], x1[3]), cvtpk(x1[4], x1[5]), cvtpk(x1[6], x1[7])}; xw3 = (u32x4){cvtpk(x1[8], x1[9]), cvtpk(x1[10], x1[11]), cvtpk(x1[12], x1[13]), cvtpk(x1[14], x1[15])};
                p1 = __builtin_amdgcn_mfma_f32_32x32x16_bf16(U0, __builtin_bit_cast(bf16x8, xw2), p1, 0, 0, 0);
                p1 = __builtin_amdgcn_mfma_f32_32x32x16_bf16(U1, __builtin_bit_cast(bf16x8, xw3), p1, 0, 0, 0);
                p0 = __builtin_amdgcn_mfma_f32_32x32x16_bf16(U0, __builtin_bit_cast(bf16x8, xw0), p0, 0, 0, 0);
                p0 = __builtin_amdgcn_mfma_f32_32x32x16_bf16(U1, __builtin_bit_cast(bf16x8, xw1), p0, 0, 0, 0);
                p0 = __builtin_amdgcn_mfma_f32_32x32x16_bf16(ONES, __builtin_bit_cast(bf16x8, xw2), p0, 0, 0, 0);
                p0 = __builtin_amdgcn_mfma_f32_32x32x16_bf16(ONES, __builtin_bit_cast(bf16x8, xw3), p0, 0, 0, 0);
                f32x16 tt = __builtin_amdgcn_mfma_f32_32x32x16_bf16(ONES, __builtin_bit_cast(bf16x8, xw0), f32x16{}, 0, 0, 0);
                tt = __builtin_amdgcn_mfma_f32_32x32x16_bf16(ONES, __builtin_bit_cast(bf16x8, xw1), tt, 0, 0, 0);
                tt = __builtin_amdgcn_mfma_f32_32x32x16_bf16(ONES, __builtin_bit_cast(bf16x8, xw2), tt, 0, 0, 0);
                tt = __builtin_amdgcn_mfma_f32_32x32x16_bf16(ONES, __builtin_bit_cast(bf16x8, xw3), tt, 0, 0, 0);
#pragma unroll
                for (int r = 0; r < 16; ++r) { p0[r] = __builtin_amdgcn_exp2f(p0[r] + R); p1[r] = __builtin_amdgcn_exp2f(p1[r] + R); }
                R += tt[0];
                if (t == 0) mydone = true;
                else if (PRUNE) mydone = __all(R < -SB_THR);
            }
            u32x4 pw0, pw1, pw2, pw3;
            pw0 = (u32x4){cvtpk(p0[0], p0[1]), cvtpk(p0[2], p0[3]), cvtpk(p0[4], p0[5]), cvtpk(p0[6], p0[7])}; pw1 = (u32x4){cvtpk(p0[8], p0[9]), cvtpk(p0[10], p0[11]), cvtpk(p0[12], p0[13]), cvtpk(p0[14], p0[15])};
            pw2 = (u32x4){cvtpk(p1[0], p1[1]), cvtpk(p1[2], p1[3]), cvtpk(p1[4], p1[5]), cvtpk(p1[6], p1[7])}; pw3 = (u32x4){cvtpk(p1[8], p1[9]), cvtpk(p1[10], p1[11]), cvtpk(p1[12], p1[13]), cvtpk(p1[14], p1[15])};
#define G_PV(OACC, DH, KS, PW) do { const bf16x8 vf_ = (bf16x8){vlo[(DH) * 4 + (KS)][0], vlo[(DH) * 4 + (KS)][1], vlo[(DH) * 4 + (KS)][2], vlo[(DH) * 4 + (KS)][3], vhi[(DH) * 4 + (KS)][0], vhi[(DH) * 4 + (KS)][1], vhi[(DH) * 4 + (KS)][2], vhi[(DH) * 4 + (KS)][3]}; \
                OACC = __builtin_amdgcn_mfma_f32_32x32x16_bf16(vf_, __builtin_bit_cast(bf16x8, PW), OACC, 0, 0, 0); } while (0)
            G_PV(o0, 0, 0, pw0); G_PV(o1, 1, 0, pw0); G_PV(o0, 0, 1, pw1); G_PV(o1, 1, 1, pw1);
            G_PV(o0, 0, 2, pw2); G_PV(o1, 1, 2, pw2); G_PV(o0, 0, 3, pw3); G_PV(o1, 1, 3, pw3);
#undef G_PV
            if (FOX) { lacc = __builtin_amdgcn_mfma_f32_32x32x16_bf16(ONES, __builtin_bit_cast(bf16x8, pw0), lacc, 0, 0, 0); lacc = __builtin_amdgcn_mfma_f32_32x32x16_bf16(ONES, __builtin_bit_cast(bf16x8, pw1), lacc, 0, 0, 0);
                       lacc = __builtin_amdgcn_mfma_f32_32x32x16_bf16(ONES, __builtin_bit_cast(bf16x8, pw2), lacc, 0, 0, 0); lacc = __builtin_amdgcn_mfma_f32_32x32x16_bf16(ONES, __builtin_bit_cast(bf16x8, pw3), lacc, 0, 0, 0); }
        }
        if (t == 0) mydone = true;
        if (mydone && !posted) { if (lane == 0) done_at[wid] = i; posted = true; }
    }
#undef G_DMA
    float inv = 1.f;
    if (FOX) inv = 1.f / lacc[0];
    float ssq = 0.f;
#pragma unroll
    for (int r = 0; r < 16; ++r) { o0[r] *= inv; o1[r] *= inv; ssq += o0[r] * o0[r] + o1[r] * o1[r]; }
    ssq += __shfl_xor(ssq, 32);
    if (hi == 0) SSQ[(size_t)(rowbase + q0 + qrel) * 16 + h16] = ssq;
    bf16* orow = F_O + (rowbase + q0 + wid * 32 + r32) * DM + h16 * 64;
#pragma unroll
    for (int g = 0; g < 4; ++g) {
        u32x2 w0 = {cvtpk(o0[4 * g], o0[4 * g + 1]), cvtpk(o0[4 * g + 2], o0[4 * g + 3])}, w1 = {cvtpk(o1[4 * g], o1[4 * g + 1]), cvtpk(o1[4 * g + 2], o1[4 * g + 3])};
        *(u32x2*)(orow + 8 * g + 4 * hi) = w0; *(u32x2*)(orow + 32 + 8 * g + 4 * hi) = w1; }
}
#undef G_WAITV
}

#define XB_TMO      128
#define XB_XCNT(j)  (256  + 64 * (j))
#define XB_XSUB(j)  (1280 + 64 * (j))
#define XB_XGEN(j)  (2304 + 64 * (j))
#define XB_TOP      3328
#define XB_TOPGEN   3392
#define XCD_BAR_WORDS 3456
#define XB_SPIN_CAP (1u << 21)
__device__ __forceinline__ unsigned xb_ld(unsigned* p)              { return __hip_atomic_load(p, __ATOMIC_RELAXED, __HIP_MEMORY_SCOPE_AGENT); }
__device__ __forceinline__ unsigned xb_add(unsigned* p, unsigned v) { return __hip_atomic_fetch_add(p, v, __ATOMIC_RELAXED, __HIP_MEMORY_SCOPE_AGENT); }
__device__ __forceinline__ unsigned xb_xcc_id() { return (unsigned)__builtin_amdgcn_s_getreg((3 << 11) | 20) & 0xFu; }
#define XB_SPIN(cond, bar) do { unsigned _sp = 0; while (cond) { __builtin_amdgcn_s_sleep(1); \
    if ((++_sp & 255u) == 0u) { if (xb_ld(&(bar)[XB_TMO])) break; if (_sp > XB_SPIN_CAP) { atomicAdd(&(bar)[XB_TMO], 1u); break; } } } } while (0)
struct XcdBarrier { unsigned* bar; unsigned x; volatile LAS unsigned* st; };
__device__ __forceinline__ XcdBarrier xcd_barrier_post(unsigned* bar, volatile LAS unsigned* st) {
    XcdBarrier b; b.bar = bar; b.x = xb_xcc_id(); b.st = st;
    if (threadIdx.x == 0) (void)xb_add(&bar[XB_XCNT(b.x)], 1u);
    return b;
}
__device__ __forceinline__ void xcd_barrier_complete(unsigned* bar, unsigned x, unsigned& nloc, unsigned& nx) {
    const unsigned G = gridDim.x * gridDim.y * gridDim.z;
    unsigned sum, cnt, mine, sp = 0u;
    for (;;) {
        sum = 0u; cnt = 0u; mine = 0u;
#pragma unroll
        for (unsigned j = 0; j < 16; ++j) { const unsigned c = xb_ld(&bar[XB_XCNT(j)]); sum += c; cnt += (c > 0u) ? 1u : 0u; mine = (j == x) ? c : mine; }
        if (sum == G) break;
        __builtin_amdgcn_s_sleep(1);
        if ((++sp & 255u) == 0u) { if (xb_ld(&bar[XB_TMO])) break; if (sp > XB_SPIN_CAP) { atomicAdd(&bar[XB_TMO], 1u); break; } }
    }
    nloc = mine > 0u ? mine : 1u; nx = cnt > 0u ? cnt : 1u;
}
__device__ __forceinline__ void xcd_barrier(const XcdBarrier& b) {
    asm volatile("s_waitcnt vmcnt(0)" ::: "memory");
    __syncthreads();
    if (threadIdx.x == 0) {
        unsigned* bar = b.bar;
        __builtin_amdgcn_s_waitcnt(0);
        unsigned nloc = b.st[0], nx = b.st[1];
        if (nloc == 0u) { xcd_barrier_complete(bar, b.x, nloc, nx); b.st[0] = nloc; b.st[1] = nx; }
        const unsigned old = xb_add(&bar[XB_XSUB(b.x)], 1u);
        const unsigned gen = old / nloc;
        if (old + 1u == (gen + 1u) * nloc) {
            __builtin_amdgcn_fence(__ATOMIC_RELEASE, "agent");
            asm volatile("s_waitcnt vmcnt(0)" ::: "memory");
            const unsigned og = xb_add(&bar[XB_TOP], 1u);
            const unsigned tg = og / nx;
            if (og + 1u == (tg + 1u) * nx) xb_add(&bar[XB_TOPGEN], 1u);
            else XB_SPIN(xb_ld(&bar[XB_TOPGEN]) == tg, bar);
            __builtin_amdgcn_fence(__ATOMIC_ACQUIRE, "agent");
            xb_add(&bar[XB_XGEN(b.x)], 1u);
            asm volatile("s_waitcnt vmcnt(0)" ::: "memory");
        } else {
            XB_SPIN(xb_ld(&bar[XB_XGEN(b.x)]) == gen, bar);
            __builtin_amdgcn_fence(__ATOMIC_ACQUIRE, "agent");
            asm volatile("s_waitcnt vmcnt(0)" ::: "memory");
        }
    }
    __syncthreads();
}

struct Args { const float* in[15]; float* out; unsigned char* ws; int ph_lo, ph_hi; };
__device__ __forceinline__ int hw_lane() { int l; asm volatile("v_mbcnt_lo_u32_b32 %0, -1, 0\n\tv_mbcnt_hi_u32_b32 %0, -1, %0" : "=v"(l)); return l; }
struct Frame {
    LAS unsigned char* lds; int tid, wave, G, bid;
    const float *x, *g_attn, *w_in, *b_forget, *g_fox, *g_sb, *w_out, *g_ffn, *w_router, *b_router, *w_gu, *b_gu, *w_d, *b_d, *g_final;
    float* out; unsigned char* ws;
};

typedef float f32x2_g __attribute__((ext_vector_type(2))); typedef __bf16 bf16x2_g __attribute__((ext_vector_type(2)));
__device__ __forceinline__ unsigned cvtpk2(float lo, float hi) { f32x2_g v = {lo, hi}; bf16x2_g r = __builtin_convertvector(v, bf16x2_g); return __builtin_bit_cast(unsigned, r); }
__device__ __forceinline__ void transpose_item(const float* W, int ldw, int K, bf16* WT, int item, int nblk, LAS unsigned* scr, int lane, const float* ks = nullptr, const float* ks2 = nullptr) {
    const int kb = item / nblk, nb = item % nblk, k0 = 64 * kb, n0 = 64 * nb, ng = lane & 15, kp = lane >> 4;
    f32x4 a[8], b[8];
#pragma unroll
    for (int i = 0; i < 8; ++i) { const float* p = W + (size_t)(k0 + 8 * i + 2 * kp) * ldw + n0 + 4 * ng; a[i] = __builtin_nontemporal_load((const f32x4*)p); b[i] = __builtin_nontemporal_load((const f32x4*)(p + ldw)); }
    if (ks) { const float* kq = (k0 < 512) ? ks + k0 : ks2 + (k0 - 512);
#pragma unroll
        for (int i = 0; i < 8; ++i) { a[i] = a[i] * kq[8 * i + 2 * kp]; b[i] = b[i] * kq[8 * i + 2 * kp + 1]; } }
#pragma unroll
    for (int i = 0; i < 8; ++i)
#pragma unroll
        for (int j = 0; j < 4; ++j) scr[(4 * ng + j) * 34 + 4 * i + kp] = cvtpk2(a[i][j], b[i][j]);
    LDS_WAIT(); asm volatile("" ::: "memory");
    const int c = lane & 7, rr = lane >> 3;
#pragma unroll
    for (int g = 0; g < 8; ++g) { const int n = 8 * g + rr; const v2u lo = *(const LAS v2u*)(scr + n * 34 + 4 * c), hi = *(const LAS v2u*)(scr + n * 34 + 4 * c + 2);
        *(GAS v4u*)(WT + (size_t)(n0 + n) * K + k0 + 8 * c) = (v4u){lo.x, lo.y, hi.x, hi.y}; }
    LDS_WAIT(); asm volatile("" ::: "memory");
}
__device__ __forceinline__ void transpose_item_fp8(const float* W, int ldw, int K, unsigned char* WT, int item, int nblk, LAS unsigned* scr, int lane, float scale) {
    const int kb = item / nblk, nb = item % nblk, k0 = 128 * kb, n0 = 32 * nb, ng = lane & 7, kq = lane >> 3;
    f32x4 r[4][4];
#pragma unroll
    for (int i = 0; i < 4; ++i)
#pragma unroll
        for (int q = 0; q < 4; ++q) r[i][q] = __builtin_nontemporal_load((const f32x4*)(W + (size_t)(k0 + 32 * i + 4 * kq + q) * ldw + n0 + 4 * ng));
#pragma unroll
    for (int i = 0; i < 4; ++i)
#pragma unroll
        for (int j = 0; j < 4; ++j) scr[(4 * ng + j) * 34 + 8 * i + kq] = pg8::cvt4_fp8(r[i][0][j] * scale, r[i][1][j] * scale, r[i][2][j] * scale, r[i][3][j] * scale);
    LDS_WAIT(); asm volatile("" ::: "memory");
    const int c = lane & 7, rr = lane >> 3;
#pragma unroll
    for (int g = 0; g < 4; ++g) { const int n = rr + 8 * g; const v2u lo = *(const LAS v2u*)(scr + n * 34 + 4 * c), hi = *(const LAS v2u*)(scr + n * 34 + 4 * c + 2);
        *(GAS v4u*)(WT + (size_t)(n0 + n) * K + k0 + 16 * c) = (v4u){lo.x, lo.y, hi.x, hi.y}; }
    LDS_WAIT(); asm volatile("" ::: "memory");
}
__device__ __forceinline__ void p0_prologue(Frame& F) {
    LAS unsigned* scr = (LAS unsigned*)(F.lds + F.wave * 16384);
    const int gw = F.bid * NWAVES + F.wave, NGW = F.G * NWAVES;
    bf16* Win_t = (bf16*)(F.ws + WS_WIN); bf16* Wout_t = (bf16*)(F.ws + WS_WOUT); bf16* Wgu_t = (bf16*)(F.ws + WS_WGU); bf16* Wd_t = (bf16*)(F.ws + WS_WD);
    constexpr int I_IN = 16 * 8, I_OUT = 16 * 16, I_GU = 8 * 64, I_D = 8 * 32;
    constexpr int NITEMS = 6 * I_IN + I_OUT;
    for (int it = gw; it < NITEMS; it += NGW) {
        int r = it;
        if (r < 6 * I_IN) { const int seg = r / I_IN; r -= seg * I_IN;
            const int src = (seg == 0) ? 0 : (seg == 1) ? 1544 : (seg == 2) ? 512 : (seg == 3) ? 2056 : (seg == 4) ? 1024 : 2568;
            transpose_item(F.w_in + src, INC, D, Win_t + (size_t)seg * 512 * D, r, 8, scr, hw_lane()); continue; }
        r -= 6 * I_IN;
        transpose_item(F.w_out, D, D, Wout_t, r, 16, scr, hw_lane(), F.g_fox, F.g_sb);
    }
    __syncthreads();
    LAS float* Wf = (LAS float*)F.lds;
    for (int i = F.tid; i < D * 8; i += NTHR) Wf[i] = F.w_in[(size_t)(i >> 3) * INC + 1536 + (i & 7)];
    __syncthreads();
    bf16* XN = (bf16*)(F.ws + WS_XN); float* LOGF = (float*)(F.ws + WS_LOGF);
    for (int m = gw; m < M; m += NGW) {
        const GAS f32x4* xr = (const GAS f32x4*)(F.x + (size_t)m * D) + hw_lane();
        f32x4 v[4]; float s = 0.f;
#pragma unroll
        for (int j = 0; j < 4; ++j) { v[j] = xr[64 * j]; s += (v[j].x * v[j].x + v[j].y * v[j].y) + (v[j].z * v[j].z + v[j].w * v[j].w); }
        const float rs = 1.0f / sqrtf(wave_sum(s) * (1.f / D) + EPS);
        float fa[8];
#pragma unroll
        for (int h = 0; h < 8; ++h) fa[h] = 0.f;
        GAS unsigned long long* o8 = (GAS unsigned long long*)(XN + (size_t)m * D) + hw_lane();
#pragma unroll
        for (int j = 0; j < 4; ++j) { const f32x4 g = *((const GAS f32x4*)F.g_attn + hw_lane() + 64 * j); v[j] = v[j] * rs * g;
            o8[64 * j] = (unsigned long long)pk2(v[j].x, v[j].y) | ((unsigned long long)pk2(v[j].z, v[j].w) << 32);
#pragma unroll
            for (int i = 0; i < 4; ++i) { const int k = 4 * hw_lane() + 256 * j + i; const f32x4 w0 = *(const LAS f32x4*)(Wf + k * 8), w1 = *(const LAS f32x4*)(Wf + k * 8 + 4); const float hv = v[j][i];
                fa[0] += hv * w0.x; fa[1] += hv * w0.y; fa[2] += hv * w0.z; fa[3] += hv * w0.w; fa[4] += hv * w1.x; fa[5] += hv * w1.y; fa[6] += hv * w1.z; fa[7] += hv * w1.w; } }
#pragma unroll
        for (int h = 0; h < 8; ++h) fa[h] = wave_sum(fa[h]);
        if (hw_lane() < 8) { float f = fa[0];
#pragma unroll
            for (int h = 1; h < 8; ++h) f = (hw_lane() == h) ? fa[h] : f;
            f += F.b_forget[hw_lane()];
            const float lf = fminf(f, 0.f) - log1pf(expf(-fabsf(f)));
            const int b = m / SEQ, s_ = m % SEQ; LOGF[(size_t)(b * 8 + hw_lane()) * SEQ + s_] = lf; }
    }
    __syncthreads();
}

__global__ void __launch_bounds__(NTHR, 2) fwd_kernel(Args args) {
    extern __shared__ __attribute__((aligned(16))) unsigned char lds[];
    Frame F;
    F.lds = (LAS unsigned char*)lds; F.tid = threadIdx.x; F.wave = __builtin_amdgcn_readfirstlane(F.tid >> 6); F.G = gridDim.x; F.bid = blockIdx.x;
    F.x = args.in[0]; F.g_attn = args.in[1]; F.w_in = args.in[2]; F.b_forget = args.in[3]; F.g_fox = args.in[4]; F.g_sb = args.in[5]; F.w_out = args.in[6]; F.g_ffn = args.in[7];
    F.w_router = args.in[8]; F.b_router = args.in[9]; F.w_gu = args.in[10]; F.b_gu = args.in[11]; F.w_d = args.in[12]; F.b_d = args.in[13]; F.g_final = args.in[14];
    F.out = args.out; F.ws = args.ws;
    volatile LAS unsigned* MISC = (volatile LAS unsigned*)(F.lds + MISC_OFF);
    for (int u = F.tid; u < (LDS_BYTES - 131072) / 4; u += NTHR) ((LAS unsigned*)(F.lds + 131072))[u] = 0u;
    __syncthreads();
    unsigned* ctl = (unsigned*)(F.ws + WS_CTL);
    XcdBarrier bar = xcd_barrier_post(ctl + CW_BAR, MISC + 8);
    const int lo = args.ph_lo, hi = args.ph_hi;
#define IN(k) (lo <= (k) && (k) < hi)
#define SEAM(k) do { if (IN(k) && IN((k) + 1)) xcd_barrier(bar); } while (0)
    LAS float* As = (LAS float*)F.lds;

    if (IN(0)) { p0_prologue(F); }
    SEAM(0);
    if (IN(1)) {
        for (int j = F.bid; j < 16; j += F.G) {
            const float* lf = (const float*)(F.ws + WS_LOGF) + (size_t)j * SEQ; float* cl = (float*)(F.ws + WS_CL) + (size_t)j * SEQ;
            LAS float* part = (LAS float*)F.lds;
            float v[16]; float s = 0.f;
#pragma unroll
            for (int i = 0; i < 16; ++i) { s += lf[F.tid * 16 + i]; v[i] = s; }
            __syncthreads(); part[F.tid] = s; __syncthreads();
            if (F.tid == 0) { float run = 0.f; for (int i = 0; i < NTHR; ++i) { const float tmp = part[i]; part[i] = run; run += tmp; } }
            __syncthreads();
            const float base = part[F.tid];
#pragma unroll
            for (int i = 0; i < 16; ++i) cl[F.tid * 16 + i] = (base + v[i]) * LOG2E;
            __syncthreads();
        }
        __syncthreads();
        { pg8::Gemm g{(const bf16*)(F.ws + WS_XN), (const bf16*)(F.ws + WS_WIN), M, 3 * D, D}; pg8::StaticOrder S; S.init(M, 3 * D, F.G, F.bid);
          pg8::EpiQKV E{(bf16*)(F.ws + WS_Q), (size_t)(WS_K - WS_Q) / 2, C2, ctl + CW_KN};
          pg8::gemm_phase<pg8::EpiQKV, pg8::StaticOrder, true, true>(F.lds, g, S, E); }
    }
    SEAM(1);
    if (IN(2)) {
        const int v0 = (F.G % 8 == 0) ? (F.bid % 8) * (F.G / 8) + F.bid / 8 : F.bid;
        if (F.tid < 16) { ((LAS unsigned*)(F.lds + att::G_DONE))[F.tid] = 0u; ((LAS unsigned*)(F.lds + att::G_ARR))[F.tid] = 0u;
                          ((LAS unsigned*)(F.lds + att::G_BYTES + att::G_DONE))[F.tid] = 0u; ((LAS unsigned*)(F.lds + att::G_BYTES + att::G_ARR))[F.tid] = 0u; }
        __syncthreads();
        const bf16* QO = (const bf16*)(F.ws + WS_Q); bf16* OB = (bf16*)(F.ws + WS_O); const bf16* KB = (const bf16*)(F.ws + WS_K); const bf16* VB = (const bf16*)(F.ws + WS_V); float* SSQ = (float*)(F.ws + WS_SSQ);
        if (F.wave < 4) { __builtin_amdgcn_s_setprio(3);
            unsigned epoch = 0u;
            for (int v = v0; v < 256; v += F.G) {
                const int bh = v >> 4, s_ = v & 15, b = bh >> 3, h = bh & 7;
                const float KN = sqrtf(__uint_as_float(ctl[CW_KN + (b * 16 + h) * 2]) + __uint_as_float(ctl[CW_KN + (b * 16 + h) * 2 + 1])) * 1.02f;
                const float* CLrow = (const float*)(F.ws + WS_CL) + (size_t)(b * 8 + h) * SEQ;
#pragma unroll 1
                for (int u = 0; u < 4; ++u) { const int qb = (u == 0) ? 63 - s_ : (u == 1) ? 47 - s_ : (u == 2) ? 16 + s_ : s_;
                    att::attn_unit4<true, ATT_PRUNE != 0>(b, h, qb, QO, OB, KB, VB, SSQ, CLrow, KN, (char*)lds, epoch);
                    if (u < 2) att::attn_unit4<false, ATT_PRUNE != 0>(b, 8 + h, qb, QO, OB, KB, VB, SSQ, nullptr, 0.f, (char*)lds, epoch); }
            }
            __builtin_amdgcn_s_setprio(0);
        } else {
            LAS unsigned* scr = (LAS unsigned*)(F.lds + att::G_BYTES + (F.wave - 4) * 4608);
            bf16* Wgu_t = (bf16*)(F.ws + WS_WGU); bf16* Wd_t = (bf16*)(F.ws + WS_WD);
            constexpr int I_GU = 8 * 64, I_D = 8 * 32;
            for (int it = v0 * 4 + (F.wave - 4); it < NE * (I_GU + I_D); it += 4 * F.G) {
                int r = it;
                if (r < NE * I_GU) { const int e = r / I_GU; r -= e * I_GU; transpose_item_fp8(F.w_gu + (size_t)e * D * 2 * DFF, 2 * DFF, D, (unsigned char*)Wgu_t + (size_t)e * 2 * DFF * D, r, 64, scr, hw_lane(), W8_SCALE); }
                else { r -= NE * I_GU; const int e = r / I_D; r -= e * I_D; transpose_item_fp8(F.w_d + (size_t)e * DFF * D, D, DFF, (unsigned char*)Wd_t + (size_t)e * D * DFF, r, 32, scr, hw_lane(), W8_SCALE); }
            }
            unsigned epoch = 0u;
            for (int v = v0; v < 256; v += F.G) {
                const int bh = v >> 4, s_ = v & 15, b = bh >> 3, h = bh & 7;
#pragma unroll 1
                for (int u = 2; u < 4; ++u) { const int qb = (u == 2) ? 16 + s_ : s_;
                    att::attn_unit4<false, ATT_PRUNE != 0>(b, 8 + h, qb, QO, OB, KB, VB, SSQ, nullptr, 0.f, (char*)lds + att::G_BYTES, epoch); }
            }
        }
        __syncthreads();
    }
    SEAM(2);
    if (IN(4)) {
        pg8::Gemm g{(const bf16*)(F.ws + WS_O), (const bf16*)(F.ws + WS_WOUT), M, D, D}; pg8::StaticOrder S; S.init(M, D, F.G, F.bid);
        pg8::EpiResMid E{F.x, (unsigned short*)(F.ws + WS_X1), D, (const float*)(F.ws + WS_SSQ), (LAS float*)(F.lds + 131072)};
        pg8::gemm_phase<pg8::EpiResMid, pg8::StaticOrder, true, true>(F.lds, g, S, E);
    }
    SEAM(4);
    if (IN(5)) {
        unsigned char* H8 = (unsigned char*)(F.ws + WS_XN); int* TOPE = (int*)(F.ws + WS_TOPE); float* GATE = (float*)(F.ws + WS_GATE); int* CNT = (int*)(F.ws + WS_CNT); const unsigned short* X1 = (const unsigned short*)(F.ws + WS_X1);
        constexpr int WP = 1028;
        LAS float* Wt = (LAS float*)F.lds;
        LAS float* Lg = (LAS float*)(F.lds + 32 * WP * 4);
        LAS float* RS = Lg + 64 * 32;
        LAS int* hist = (LAS int*)(RS + 64);
        __syncthreads();
        { f32x4 wv[16];
#pragma unroll
          for (int it = 0; it < 16; ++it) wv[it] = ((const GAS f32x4*)F.w_router)[F.tid + it * NTHR];
#pragma unroll
          for (int it = 0; it < 16; ++it) { const int i = F.tid + it * NTHR; const int k = i >> 3, e0 = (i & 7) * 4; const f32x4 w = wv[it] * F.g_ffn[k];
            Wt[(e0 + 0) * WP + k] = w.x; Wt[(e0 + 1) * WP + k] = w.y; Wt[(e0 + 2) * WP + k] = w.z; Wt[(e0 + 3) * WP + k] = w.w; } }
        const int ln = hw_lane(), mt = F.wave >> 1, kh = F.wave & 1, r16 = ln & 15, kq = ln >> 4;
        const float brt0 = F.b_router[r16], brt1 = F.b_router[16 + r16];
        LAS float* Pp = Lg;
        for (int vb = F.bid; vb < NVB; vb += F.G) {
            __syncthreads(); if (F.tid < NE) hist[F.tid] = 0;
            v2u_b xv[VBT / NWAVES][4];
            { const unsigned short* xrow = X1 + (size_t)(vb * VBT + mt * 16 + r16) * D + 512 * kh + 4 * kq; const LAS float* wrow = Wt + r16 * WP + 512 * kh + 4 * kq;
              f32x4 acc0 = {0.f, 0.f, 0.f, 0.f}, acc1 = {0.f, 0.f, 0.f, 0.f}; float ssq = 0.f;
              v2u_b nx[8];
#pragma unroll
              for (int u = 0; u < 8; ++u) nx[u] = *(const GAS v2u_b*)(xrow + 16 * u);
#pragma unroll 1
              for (int i0 = 0; i0 < 32; i0 += 8) { f32x4 av[8];
#pragma unroll
                  for (int u = 0; u < 8; ++u) av[u] = bf4(nx[u]);
                  if (i0 + 8 < 32) {
#pragma unroll
                      for (int u = 0; u < 8; ++u) nx[u] = *(const GAS v2u_b*)(xrow + 16 * (i0 + 8 + u)); }
#pragma unroll
                  for (int u = 0; u < 8; ++u) { const f32x4 b0 = *(const LAS f32x4*)(wrow + 16 * (i0 + u)), b1 = *(const LAS f32x4*)(wrow + 16 * WP + 16 * (i0 + u)); const f32x4 a = av[u];
                      ssq += (a.x * a.x + a.y * a.y) + (a.z * a.z + a.w * a.w);
                      acc0 = __builtin_amdgcn_mfma_f32_16x16x4f32(a.x, b0.x, acc0, 0, 0, 0); acc1 = __builtin_amdgcn_mfma_f32_16x16x4f32(a.x, b1.x, acc1, 0, 0, 0);
                      acc0 = __builtin_amdgcn_mfma_f32_16x16x4f32(a.y, b0.y, acc0, 0, 0, 0); acc1 = __builtin_amdgcn_mfma_f32_16x16x4f32(a.y, b1.y, acc1, 0, 0, 0);
                      acc0 = __builtin_amdgcn_mfma_f32_16x16x4f32(a.z, b0.z, acc0, 0, 0, 0); acc1 = __builtin_amdgcn_mfma_f32_16x16x4f32(a.z, b1.z, acc1, 0, 0, 0);
                      acc0 = __builtin_amdgcn_mfma_f32_16x16x4f32(a.w, b0.w, acc0, 0, 0, 0); acc1 = __builtin_amdgcn_mfma_f32_16x16x4f32(a.w, b1.w, acc1, 0, 0, 0); } }
#pragma unroll
              for (int rr = 0; rr < VBT / NWAVES; ++rr) { const GAS v2u_b* xr = (const GAS v2u_b*)(X1 + (size_t)(vb * VBT + F.wave * (VBT / NWAVES) + rr) * D) + ln;
#pragma unroll
                  for (int j = 0; j < 4; ++j) xv[rr][j] = xr[64 * j]; }
              ssq += __shfl_xor(ssq, 16); ssq += __shfl_xor(ssq, 32);
              if (kh == 1) { *(LAS f32x4*)(Pp + ((mt * 2 + 0) * 64 + ln) * 4) = acc0; *(LAS f32x4*)(Pp + ((mt * 2 + 1) * 64 + ln) * 4) = acc1; if (kq == 0) RS[mt * 16 + r16] = ssq; }
              __syncthreads();
              if (kh == 0) { const f32x4 q0 = *(const LAS f32x4*)(Pp + ((mt * 2 + 0) * 64 + ln) * 4), q1 = *(const LAS f32x4*)(Pp + ((mt * 2 + 1) * 64 + ln) * 4);
                  acc0 = acc0 + q0; acc1 = acc1 + q1; ssq += RS[mt * 16 + r16];
                  const float rsr = 1.0f / sqrtf(ssq * (1.f / D) + EPS);
                  if (kq == 0) RS[mt * 16 + r16] = rsr;
#pragma unroll
                  for (int j = 0; j < 4; ++j) { const int row = 4 * kq + j; const float rsj = __shfl(rsr, row);
                      Lg[(mt * 16 + row) * 32 + r16] = acc0[j] * rsj + brt0; Lg[(mt * 16 + row) * 32 + 16 + r16] = acc1[j] * rsj + brt1; } } }
            __syncthreads();
#pragma unroll
            for (int rr = 0; rr < VBT / NWAVES; ++rr) {
                const int row = F.wave * (VBT / NWAVES) + rr, m = vb * VBT + row;
                f32x4 v[4];
#pragma unroll
                for (int j = 0; j < 4; ++j) v[j] = bf4(xv[rr][j]);
                const float vv = Lg[row * 32 + (ln & 31)]; const int myi = ln & 31; int rank = 0;
#pragma unroll
                for (int e = 0; e < NE; ++e) { const float se = __builtin_bit_cast(float, __builtin_amdgcn_readlane(__builtin_bit_cast(int, vv), e)); rank += (se > vv || (se == vv && e < myi)) ? 1 : 0; }
                float sv[TOPK]; int si[TOPK];
#pragma unroll
                for (int r = 0; r < TOPK; ++r) { const unsigned long long mk = __ballot(rank == r && ln < 32); const int li = __builtin_amdgcn_readfirstlane((int)__builtin_ctzll(mk));
                    si[r] = li; sv[r] = __builtin_bit_cast(float, __builtin_amdgcn_readlane(__builtin_bit_cast(int, vv), li)); }
                if (ln == 0) { const float x1_ = expf(sv[1] - sv[0]), x2_ = expf(sv[2] - sv[0]), x3_ = expf(sv[3] - sv[0]); const float inv = 1.f / (1.f + x1_ + x2_ + x3_);
                    *(GAS f32x4*)(GATE + (size_t)m * 4) = (f32x4){inv, x1_ * inv, x2_ * inv, x3_ * inv};
                    TOPE[(size_t)m * 4 + 0] = si[0]; TOPE[(size_t)m * 4 + 1] = si[1]; TOPE[(size_t)m * 4 + 2] = si[2]; TOPE[(size_t)m * 4 + 3] = si[3];
                    atomicAdd((int*)&hist[si[0]], 1); atomicAdd((int*)&hist[si[1]], 1); atomicAdd((int*)&hist[si[2]], 1); atomicAdd((int*)&hist[si[3]], 1); }
                const float rs = RS[row] * X8_SCALE;
                GAS unsigned* o4 = (GAS unsigned*)(H8 + (size_t)m * D) + ln;
#pragma unroll
                for (int j = 0; j < 4; ++j) { const f32x4 g = *((const GAS f32x4*)F.g_ffn + ln + 64 * j); const f32x4 h = v[j] * rs * g; o4[64 * j] = pg8::cvt4_fp8(h.x, h.y, h.z, h.w); }
            }
            __syncthreads();
            if (F.tid < NE) CNT[vb * NE + F.tid] = hist[F.tid];
        }
        __syncthreads();
    }
    SEAM(5);
    if (IN(6)) {
        const int* TOPE = (const int*)(F.ws + WS_TOPE); const float* GATE = (const float*)(F.ws + WS_GATE); const int* CNT = (const int*)(F.ws + WS_CNT);
        int* ROWTOK = (int*)(F.ws + WS_ROWTOK); int* ROWDST = (int*)(F.ws + WS_ROWDST); float* GSLOT = (float*)(F.ws + WS_GSLOT2); int* TILE = (int*)(F.ws + WS_TILE);
        LAS int* es = (LAS int*)F.lds; LAS int* tot = es + 256; LAS int* bef = tot + 32; LAS int* ps = bef + 32; LAS int* part = ps + 32;
        for (int vb = F.bid; vb < NVB; vb += F.G) {
            __syncthreads();
            if (F.tid < 256) es[F.tid] = TOPE[(size_t)vb * VBT * 4 + F.tid];
            { const int e = F.tid & 31, qg = F.tid >> 5; int cv[16];
#pragma unroll
              for (int i = 0; i < 16; ++i) cv[i] = CNT[(qg * 16 + i) * NE + e];
              int t_ = 0, b_ = 0;
#pragma unroll
              for (int i = 0; i < 16; ++i) { t_ += cv[i]; b_ += (qg * 16 + i < vb) ? cv[i] : 0; }
              part[qg * 32 + e] = t_; part[512 + qg * 32 + e] = b_; }
            __syncthreads();
            if (F.tid < NE) { int t_ = 0, b_ = 0;
#pragma unroll
                for (int qg = 0; qg < 16; ++qg) { t_ += part[qg * 32 + F.tid]; b_ += part[512 + qg * 32 + F.tid]; }
                tot[F.tid] = t_; bef[F.tid] = b_; }
            __syncthreads();
            if (F.tid < NE) { int nt = 0;
                for (int e = 0; e < F.tid; ++e) nt += (tot[e] + 255) / 256;
                ps[F.tid] = nt * 256;
                if (vb == NE) { const int k = (tot[F.tid] + 255) / 256; for (int i = 0; i < k; ++i) TILE[16 + nt + i] = F.tid; if (F.tid == NE - 1) TILE[0] = nt + k; } }
            __syncthreads();
            if (F.tid < 256) { const int e = es[F.tid]; int rank = 0;
#pragma unroll 8
                for (int j4 = 0; j4 < 64; ++j4) { const v4u q = *(const LAS v4u*)(es + 4 * j4); const int j = 4 * j4;
                    rank += ((int)q.x == e && j < F.tid) + ((int)q.y == e && j + 1 < F.tid) + ((int)q.z == e && j + 2 < F.tid) + ((int)q.w == e && j + 3 < F.tid); }
                const int slot = ps[e] + bef[e] + rank; const int a = vb * VBT * 4 + F.tid; ROWTOK[slot] = a >> 2; ROWDST[slot] = a; GSLOT[slot] = GATE[a];  }
            if (vb < NE) {
                const int n0 = ps[vb] + tot[vb], n1 = ps[vb] + (tot[vb] + 255) / 256 * 256;
                for (int r = n0 + F.tid; r < n1; r += NTHR) { ROWTOK[r] = 0; ROWDST[r] = -1; GSLOT[r] = 0.f; } }
        }
    }
    SEAM(6);
    if (IN(7)) {
        pg8::Gemm g{(const bf16*)(F.ws + WS_XN), (const bf16*)(F.ws + WS_WGU), MAXROWS, 2 * DFF, D / 2}; pg8::GroupedOrder S; S.init((const int*)(F.ws + WS_TILE), 8, F.G, F.bid);
        pg8::EpiSwiglu E{(unsigned char*)(F.ws + WS_ACT), F.b_gu, 1.f / (X8_SCALE * W8_SCALE), A8_SCALE};
        pg8::gemm_phase<pg8::EpiSwiglu, pg8::GroupedOrder, true, true, true, true>(F.lds, g, S, E, (const int*)(F.ws + WS_ROWTOK));
    }
    SEAM(7);
    if (IN(8)) {
        pg8::Gemm g{(const bf16*)(F.ws + WS_ACT), (const bf16*)(F.ws + WS_WD), MAXROWS, D, DFF / 2}; pg8::GroupedOrder S; S.init((const int*)(F.ws + WS_TILE), 4, F.G, F.bid);
        pg8::EpiDownG E{(unsigned char*)(F.ws + WS_XS), F.b_d, (const float*)(F.ws + WS_GSLOT2), (const int*)(F.ws + WS_ROWDST), 1.f / (A8_SCALE * W8_SCALE), Y8_SCALE};
        pg8::gemm_phase<pg8::EpiDownG, pg8::GroupedOrder, true, true, false, true>(F.lds, g, S, E);
    }
    SEAM(8);
    if (IN(9)) {
        const bf16* Y = (const bf16*)(F.ws + WS_XS);
        const int gw = F.bid * NWAVES + F.wave, NGW = F.G * NWAVES;
        for (int m = gw; m < M; m += NGW) {
            GAS f32x4* xr = (GAS f32x4*)(F.out + (size_t)m * D) + hw_lane(); const GAS v2u_b* x1r = (const GAS v2u_b*)((const unsigned short*)(F.ws + WS_X1) + (size_t)m * D) + hw_lane();
            f32x4 v[4];
#pragma unroll
            for (int j = 0; j < 4; ++j) v[j] = bf4(x1r[64 * j]);
#pragma unroll
            for (int k = 0; k < TOPK; ++k) { const GAS unsigned* yr = (const GAS unsigned*)((const unsigned char*)Y + ((size_t)m * 4 + k) * D) + hw_lane();
#pragma unroll
                for (int j = 0; j < 4; ++j) { const unsigned w = yr[64 * j]; typedef float f2_ __attribute__((ext_vector_type(2))); const f2_ lo = __builtin_amdgcn_cvt_pk_f32_fp8((int)w, false), hi = __builtin_amdgcn_cvt_pk_f32_fp8((int)w, true);
                    v[j].x += lo.x * (1.f / Y8_SCALE); v[j].y += lo.y * (1.f / Y8_SCALE); v[j].z += hi.x * (1.f / Y8_SCALE); v[j].w += hi.y * (1.f / Y8_SCALE); } }
            float s = 0.f;
#pragma unroll
            for (int j = 0; j < 4; ++j) s += (v[j].x * v[j].x + v[j].y * v[j].y) + (v[j].z * v[j].z + v[j].w * v[j].w);
            const float rs = 1.0f / sqrtf(wave_sum(s) * (1.f / D) + EPS);
#pragma unroll
            for (int j = 0; j < 4; ++j) { const f32x4 g = *((const GAS f32x4*)F.g_final + hw_lane() + 64 * j); xr[64 * j] = v[j] * rs * g; }
        }
    }
#undef IN
#undef SEAM
}

extern "C" void kernel_launch(void* const* d_in, const int* in_sizes, int n_in, void* d_out, int out_size, void* d_ws, size_t ws_size, hipStream_t stream) {
    static int grid = 0;
    if (grid == 0) {
        if (n_in != 15 || out_size != M * D || ws_size < WS_END) { fprintf(stderr, "kernel_launch: unexpected problem (n_in %d out %d ws %zu)\n", n_in, out_size, ws_size); grid = -1; return; }
        int dev = 0, cus = 0, per_cu = 0;
        if (hipGetDevice(&dev) != hipSuccess || hipDeviceGetAttribute(&cus, hipDeviceAttributeMultiprocessorCount, dev) != hipSuccess) { grid = -1; return; }
        if (hipFuncSetAttribute((const void*)fwd_kernel, hipFuncAttributeMaxDynamicSharedMemorySize, LDS_BYTES) != hipSuccess) { fprintf(stderr, "kernel_launch: hipFuncSetAttribute failed\n"); grid = -1; return; }
        if (hipOccupancyMaxActiveBlocksPerMultiprocessor(&per_cu, (const void*)fwd_kernel, NTHR, LDS_BYTES) != hipSuccess || per_cu < 1) { fprintf(stderr, "kernel_launch: occupancy query says %d blocks/CU\n", per_cu); (void)hipGetLastError(); grid = -1; return; }
        grid = cus;
    }
    if (grid < 0) return;
    if (hipMemsetAsync((char*)d_ws + WS_CTL, 0, CTL_ZERO_BYTES, stream) != hipSuccess) return;
    Args a{};
    for (int i = 0; i < 15; ++i) a.in[i] = (const float*)d_in[i];
    a.out = (float*)d_out; a.ws = (unsigned char*)d_ws; a.ph_lo = 0; a.ph_hi = 10;
    hipLaunchKernelGGL(fwd_kernel, dim3(grid), dim3(NTHR), LDS_BYTES, stream, a);
}
```

```cpp
#include <hip/hip_runtime.h>
#include <cstdio>
#include <cstdint>

#define GAS __attribute__((address_space(1)))
#define LAS __attribute__((address_space(3)))
typedef unsigned short bf16;
typedef float f32x4 __attribute__((ext_vector_type(4)));
typedef unsigned v4u __attribute__((ext_vector_type(4)));
typedef unsigned v2u __attribute__((ext_vector_type(2)));
typedef GAS unsigned gu32;
#define RLX_AGENT __ATOMIC_RELAXED, __HIP_MEMORY_SCOPE_AGENT
#define LDS_WAIT() asm volatile("s_waitcnt lgkmcnt(0)" ::: "memory")
#define VM_WAIT() asm volatile("s_waitcnt vmcnt(0)" ::: "memory")

constexpr int BATCH = 2, SEQ = 8192, D = 1024, M = BATCH * SEQ, NH = 16  , HD = 64;
constexpr int INC = 3080, NE = 32, TOPK = 4, DFF = 1024;
constexpr float EPS = 1e-5f, LOG2E = 1.4426950408889634f, C2 = 0.125f * 1.4426950408889634f;
constexpr int MAXTILES = 288, MAXROWS = MAXTILES * 256;
constexpr int NWAVES = 8, NTHR = 512;
constexpr float W8_SCALE = 64.f, X8_SCALE = 16.f, A8_SCALE = 8.f, Y8_SCALE = 32.f;
constexpr int NVB = 256, VBT = M / NVB;

constexpr size_t MiB = 1u << 20;
constexpr size_t WS_CTL = 0, CTL_ZERO_BYTES = 64 * 1024;
constexpr size_t WS_WIN = 2 * MiB, WS_WOUT = 8 * MiB, WS_WGU = 16 * MiB, WS_WD = 144 * MiB;
constexpr size_t WS_XN = 208 * MiB;
constexpr size_t WS_SSQ = 240 * MiB;
constexpr size_t WS_LOGF = 241 * MiB, WS_CL = WS_LOGF + 512 * 1024;
constexpr size_t WS_TOPE = 242 * MiB, WS_GATE = WS_TOPE + 256 * 1024, WS_SLOT = WS_GATE + 256 * 1024, WS_GSLOT = WS_SLOT + 256 * 1024;
constexpr size_t WS_CNT = 243 * MiB + 256 * 1024, WS_TILE = 243 * MiB + 512 * 1024;
constexpr size_t WS_ROWTOK = 244 * MiB, WS_ROWDST = WS_ROWTOK + 512 * 1024, WS_GSLOT2 = WS_ROWDST + 512 * 1024;
constexpr size_t WS_Q = 256 * MiB, WS_K = 288 * MiB, WS_V = 320 * MiB;
constexpr size_t WS_O = 352 * MiB;
constexpr size_t WS_XS = 256 * MiB;
constexpr size_t WS_ACT = 400 * MiB;
constexpr size_t WS_XS8 = 480 * MiB;
constexpr size_t WS_X1 = 560 * MiB;
constexpr size_t WS_END = 624 * MiB;
constexpr int CW_BAR = 4096, CW_KN = 8192;
#ifndef ATT_PRUNE
#define ATT_PRUNE 1
#endif

constexpr int LDS_BYTES = 147456;
constexpr int MISC_OFF = LDS_BYTES - 128;

__device__ __forceinline__ unsigned f2bf(float f) { unsigned u = __builtin_bit_cast(unsigned, f); return (u + 0x7fffu + ((u >> 16) & 1u)) >> 16; }
__device__ __forceinline__ unsigned pk2(float lo, float hi) { return f2bf(lo) | (f2bf(hi) << 16); }
typedef unsigned v2u_b __attribute__((ext_vector_type(2)));
__device__ __forceinline__ f32x4 bf4(v2u_b w) { return (f32x4){__uint_as_float(w.x << 16), __uint_as_float(w.x & 0xffff0000u), __uint_as_float(w.y << 16), __uint_as_float(w.y & 0xffff0000u)}; }
__device__ __forceinline__ float bflo(unsigned w) { return __builtin_bit_cast(float, w << 16); }
__device__ __forceinline__ float bfhi(unsigned w) { return __builtin_bit_cast(float, w & 0xffff0000u); }
__device__ __forceinline__ float wave_sum(float v) {
#pragma unroll
    for (int o = 1; o < 64; o <<= 1) v += __shfl_xor(v, o);
    return v;
}

namespace pg8 {
#define PG8_LAS __attribute__((address_space(3)))
typedef unsigned short bf16_t;
typedef short bf16x8 __attribute__((ext_vector_type(8)));
typedef float f32x4 __attribute__((ext_vector_type(4)));
typedef unsigned u32x4 __attribute__((ext_vector_type(4)));
typedef unsigned u32x2 __attribute__((ext_vector_type(2)));
typedef int i32x4_t __attribute__((ext_vector_type(4)));
constexpr int BM = 256, BK = 64, HALF = 128, HTB = HALF * BK * 2  , STAGE_BYTES = 8 * HTB, NXCD = 8, WGM = 8;

__host__ __device__ __forceinline__ int lds_byte(int r, int c) { const int st = (r >> 4) * 2 + (c >> 5), rr = r & 15, cc = c & 31, ob = rr * 64 + cc * 2; return st * 1024 + (ob ^ (((ob >> 9) & 1) << 5)); }
__host__ __device__ __forceinline__ void stage_rc(int b, int& R, int& C) { const int st = b / 1024, sb = b % 1024, swz = sb ^ (((sb >> 9) & 1) << 5); R = (st >> 1) * 16 + swz / 64; C = (st & 1) * 32 + (swz % 64) / 2; }
__host__ __device__ __forceinline__ int perm32(int rho) { const int n = rho >> 4, i = rho & 15; return 8 * (i >> 2) + 4 * n + (i & 3); }

struct Unit { int pm, pn; };
struct Gemm { const bf16_t* A; const bf16_t* Bt; int M, N, K; };

struct StaticOrder {
    int nM, nN, nwg, G, c;
    __host__ __device__ void init(int M, int N, int G_, int c_) { nM = M / BM; nN = N / BM; nwg = nM * nN; G = G_; c = c_; }
    __host__ __device__ bool next(int i, Unit& u) const {
        const long L = (long)i * G + c; if (L >= nwg) return false;
        int wgid = (int)L; { const int q = nwg / NXCD, r = nwg % NXCD, xcd = wgid % NXCD, off = wgid / NXCD; wgid = (xcd < r ? xcd * (q + 1) : r * (q + 1) + (xcd - r) * q) + off; }
        const int nig = WGM * nN, gid = wgid / nig, fm = gid * WGM, gsz = (nM - fm) < WGM ? (nM - fm) : WGM;
        u.pm = fm + ((wgid % nig) % gsz); u.pn = (wgid % nig) / gsz; return true;
    }
    __device__ __forceinline__ void a_ready(const Unit&) const {}
    __device__ __forceinline__ void done(const Unit&) const {}
};
__device__ __forceinline__ unsigned cvt_pk_bf16(float lo, float hi) { unsigned r; asm volatile("v_cvt_pk_bf16_f32 %0, %1, %2" : "=v"(r) : "v"(lo), "v"(hi)); return r; }
typedef float f32x2 __attribute__((ext_vector_type(2)));
__device__ __forceinline__ f32x2 gelu_pk(f32x2 v) {
    const f32x2 av = __builtin_elementwise_abs(v), d = av * 0.2316418882f + 1.0f;
    f32x2 t; t.x = __builtin_amdgcn_rcpf(d.x); t.y = __builtin_amdgcn_rcpf(d.y);
    f32x2 q = t * 0.5307027145f + (-0.7265760135f); q = q * t + 0.7107068705f; q = q * t + (-0.142248368f); q = q * t + 0.127414796f; q = q * t;
    const f32x2 s = (v * v) * (-0.72134752044f);
    f32x2 e; e.x = __builtin_amdgcn_exp2f(s.x); e.y = __builtin_amdgcn_exp2f(s.y);
    const f32x2 m = v * (q * e), r = v - m;
    f32x2 o; o.x = v.x < 0.f ? m.x : r.x; o.y = v.y < 0.f ? m.y : r.y; return o;
}

template <int ACT  > struct EpiBf16 {
    static constexpr bool PERM = true, AFTER_DRAIN = false, MIDK = false; static_assert(ACT == 0 || ACT == 1, "EpiBf16: ACT is 0 (none) or 1 (gelu_pk)");
    bf16_t* O; int ldc; const float* bias; int split_cols; size_t split_stride; float scale0;
    __device__ __forceinline__ void operator()(const f32x4 (&acc)[2][2][4][2], const Unit& u, int wr, int wc, int fr, int fq) const {
        const int row0 = u.pm * BM + wr * 64 + fr; int colt = u.pn * BM; bf16_t* base = O;
        float sc = 1.f; if (split_cols) { const int t = colt / split_cols; base += (size_t)t * split_stride; colt -= t * split_cols; if (t == 0) sc = scale0; }
        const int col0 = colt + wc * 32 + 8 * fq, bcol0 = u.pn * BM + wc * 32 + 8 * fq;
        f32x4 bv[2][2];
#pragma unroll
        for (int bj = 0; bj < 2; ++bj)
#pragma unroll
            for (int n = 0; n < 2; ++n) bv[bj][n] = bias ? *(const f32x4*)(bias + bcol0 + bj * HALF + 4 * n) : (f32x4){0.f, 0.f, 0.f, 0.f};
#pragma unroll
        for (int ai = 0; ai < 2; ++ai)
#pragma unroll
            for (int m = 0; m < 4; ++m) { bf16_t* rowp = base + (size_t)(row0 + ai * HALF + m * 16) * ldc + col0;
#pragma unroll
                for (int bj = 0; bj < 2; ++bj) { f32x4 v0 = acc[ai][bj][m][0] + bv[bj][0], v1 = acc[ai][bj][m][1] + bv[bj][1];
                    if (ACT == 1) { f32x2 a = gelu_pk((f32x2){v0[0], v0[1]}), b = gelu_pk((f32x2){v0[2], v0[3]}), c = gelu_pk((f32x2){v1[0], v1[1]}), d = gelu_pk((f32x2){v1[2], v1[3]});
                        v0 = (f32x4){a.x, a.y, b.x, b.y}; v1 = (f32x4){c.x, c.y, d.x, d.y}; }
                    v0 = v0 * sc; v1 = v1 * sc; u32x4 w; w.x = cvt_pk_bf16(v0[0], v0[1]); w.y = cvt_pk_bf16(v0[2], v0[3]); w.z = cvt_pk_bf16(v1[0], v1[1]); w.w = cvt_pk_bf16(v1[2], v1[3]);
                    *(u32x4*)(rowp + bj * HALF) = w; } }
    }
};

struct EpiResF32 { static constexpr bool PERM = false, AFTER_DRAIN = false, MIDK = false; const float* base; float* out; int ldc;
    __device__ __forceinline__ void operator()(const f32x4 (&acc)[2][2][4][2], const Unit& u, int wr, int wc, int fr, int fq) const {
        const int col0 = u.pn * BM + wc * 32 + 4 * fq;
#pragma unroll
        for (int ai = 0; ai < 2; ++ai)
#pragma unroll
            for (int m = 0; m < 4; ++m) { const size_t off = (size_t)(u.pm * BM + ai * HALF + wr * 64 + m * 16 + fr) * ldc + col0;
#pragma unroll
                for (int bj = 0; bj < 2; ++bj)
#pragma unroll
                    for (int n = 0; n < 2; ++n) { const f32x4 b = *(const f32x4*)(base + off + bj * HALF + n * 16); *(f32x4*)(out + off + bj * HALF + n * 16) = b + acc[ai][bj][m][n]; } }
    } };

struct EpiResMid { static constexpr bool PERM = false, AFTER_DRAIN = false, MIDK = true; const float* base; unsigned short* out; int ldc; const float* ssq; PG8_LAS float* tab;
    __device__ __forceinline__ void prep(const Unit& u, int par, int tid) const {
        if (tid < 256) { const f32x4* sp = (const f32x4*)(ssq + (size_t)(u.pm * BM + tid) * 16); const f32x4 s0 = sp[0], s1 = sp[1], s2 = sp[2], s3 = sp[3];
            const float sa = (s0[0] + s0[1]) + (s0[2] + s0[3]) + (s1[0] + s1[1]) + (s1[2] + s1[3]), sb = (s2[0] + s2[1]) + (s2[2] + s2[3]) + (s3[0] + s3[1]) + (s3[2] + s3[3]);
            const float rsa = 1.0f / sqrtf(sa * (1.f / 512.f) + 1e-5f), rsb = 1.0f / sqrtf(sb * (1.f / 512.f) + 1e-5f);
            tab[(par * 256 + tid) * 2] = rsa / rsb; tab[(par * 256 + tid) * 2 + 1] = rsb; } }
    __device__ __forceinline__ void midk(f32x4 (&acc)[2][2][4][2], int par, int wr, int fr) const {
#pragma unroll
        for (int ai = 0; ai < 2; ++ai)
#pragma unroll
            for (int m = 0; m < 4; ++m) { const float f = tab[(par * 256 + ai * HALF + wr * 64 + m * 16 + fr) * 2];
#pragma unroll
                for (int bj = 0; bj < 2; ++bj)
#pragma unroll
                    for (int n = 0; n < 2; ++n) acc[ai][bj][m][n] *= f; } }
    __device__ __forceinline__ void epi(const f32x4 (&acc)[2][2][4][2], const Unit& u, int par, int wr, int wc, int fr, int fq) const {
        const int col0 = u.pn * BM + wc * 32 + 4 * fq;
#pragma unroll
        for (int ai = 0; ai < 2; ++ai)
#pragma unroll
            for (int m = 0; m < 4; ++m) { const int r = ai * HALF + wr * 64 + m * 16 + fr; const float f = tab[(par * 256 + r) * 2 + 1]; const size_t off = (size_t)(u.pm * BM + r) * ldc + col0;
#pragma unroll
                for (int bj = 0; bj < 2; ++bj)
#pragma unroll
                    for (int n = 0; n < 2; ++n) { const f32x4 b = *(const f32x4*)(base + off + bj * HALF + n * 16); const f32x4 v = b + acc[ai][bj][m][n] * f;
                        u32x2 w; w.x = cvt_pk_bf16(v[0], v[1]); w.y = cvt_pk_bf16(v[2], v[3]); *(u32x2*)(out + off + bj * HALF + n * 16) = w; } } }
    __device__ __forceinline__ void operator()(const f32x4 (&)[2][2][4][2], const Unit&, int, int, int, int) const {}
};
__device__ __forceinline__ float sgpr_f(unsigned bits) { return __builtin_bit_cast(float, __builtin_amdgcn_readfirstlane((int)bits)); }
__device__ __forceinline__ float swiglu1(float g, float u) { const float c7 = sgpr_f(0x40e00000u); g = fminf(g, c7); u = fminf(fmaxf(u, -c7), c7); const float s = __builtin_amdgcn_rcpf(1.f + __builtin_amdgcn_exp2f(g * (-1.702f * 1.4426950408889634f))); return g * s * (u + 1.f); }
__device__ __forceinline__ unsigned cvt4_fp8(float a, float b, float c, float d) {
    const float mx = __builtin_bit_cast(float, __builtin_amdgcn_readfirstlane(0x43e00000)); a = fminf(fmaxf(a, -mx), mx); b = fminf(fmaxf(b, -mx), mx); c = fminf(fmaxf(c, -mx), mx); d = fminf(fmaxf(d, -mx), mx);
    int w = 0; w = __builtin_amdgcn_cvt_pk_fp8_f32(a, b, w, false); w = __builtin_amdgcn_cvt_pk_fp8_f32(c, d, w, true); return (unsigned)w; }
struct EpiSwiglu { static constexpr bool PERM = true, AFTER_DRAIN = false, MIDK = false; unsigned char* ACT; const float* bias; float sc_in, sc_out;
    __device__ __forceinline__ void operator()(const f32x4 (&acc)[2][2][4][2], const Unit& u, int wr, int wc, int fr, int fq) const {
        const int e = u.pn >> 3, pn = u.pn & 7; const int colg = pn * BM + wc * 32 + 8 * fq; const int row0 = u.pm * BM + wr * 64 + fr;
        f32x4 bv[2][2];
#pragma unroll
        for (int bj = 0; bj < 2; ++bj)
#pragma unroll
            for (int n = 0; n < 2; ++n) bv[bj][n] = *(const f32x4*)(bias + (size_t)e * 2048 + colg + bj * HALF + 4 * n);
#pragma unroll
        for (int ai = 0; ai < 2; ++ai)
#pragma unroll
            for (int m = 0; m < 4; ++m) { unsigned char* rowp = ACT + (size_t)(row0 + ai * HALF + m * 16) * 1024 + (colg >> 1);
#pragma unroll
                for (int bj = 0; bj < 2; ++bj) { const f32x4 v0 = acc[ai][bj][m][0] * sc_in + bv[bj][0], v1 = acc[ai][bj][m][1] * sc_in + bv[bj][1];
                    *(unsigned*)(rowp + bj * (HALF / 2)) = cvt4_fp8(swiglu1(v0[0], v0[1]) * sc_out, swiglu1(v0[2], v0[3]) * sc_out, swiglu1(v1[0], v1[1]) * sc_out, swiglu1(v1[2], v1[3]) * sc_out); } }
    } };
struct EpiDownG { static constexpr bool PERM = true, AFTER_DRAIN = false, MIDK = false; unsigned char* Y; const float* bias; const float* gs; const int* rowdst; float sc_in, sc_out;
    __device__ __forceinline__ void operator()(const f32x4 (&acc)[2][2][4][2], const Unit& u, int wr, int wc, int fr, int fq) const {
        const int e = u.pn >> 2, pn = u.pn & 3; const int col = pn * BM + wc * 32 + 8 * fq; const int row0 = u.pm * BM + wr * 64 + fr;
        f32x4 bv[2][2];
#pragma unroll
        for (int bj = 0; bj < 2; ++bj)
#pragma unroll
            for (int n = 0; n < 2; ++n) bv[bj][n] = *(const f32x4*)(bias + (size_t)e * 1024 + col + bj * HALF + 4 * n);
#pragma unroll
        for (int ai = 0; ai < 2; ++ai)
#pragma unroll
            for (int m = 0; m < 4; ++m) { const int row = row0 + ai * HALF + m * 16; const float g = gs[row] * sc_out; const int dst = rowdst[row];
                if (dst >= 0) { unsigned char* rowp = Y + (size_t)dst * 1024 + col;
#pragma unroll
                    for (int bj = 0; bj < 2; ++bj) { const f32x4 v0 = (acc[ai][bj][m][0] * sc_in + bv[bj][0]) * g, v1 = (acc[ai][bj][m][1] * sc_in + bv[bj][1]) * g;
                        typedef unsigned u32x2v __attribute__((ext_vector_type(2))); u32x2v w; w.x = cvt4_fp8(v0[0], v0[1], v0[2], v0[3]); w.y = cvt4_fp8(v1[0], v1[1], v1[2], v1[3]);
                        *(u32x2v*)(rowp + bj * HALF) = w; } } }
    } };
struct EpiQKV { static constexpr bool PERM = true, AFTER_DRAIN = false, MIDK = false; bf16_t* O; size_t split_stride; float scale0; unsigned* kn2;
    __device__ __forceinline__ void operator()(const f32x4 (&acc)[2][2][4][2], const Unit& u, int wr, int wc, int fr, int fq) const {
        const int row0 = u.pm * BM + wr * 64 + fr; int colt = u.pn * BM; const int t = colt / 1024; bf16_t* base = O + (size_t)t * split_stride; colt -= t * 1024; const float sc = (t == 0) ? scale0 : 1.f;
        const int col0 = colt + wc * 32 + 8 * fq;
        float mx[2] = {0.f, 0.f};
#pragma unroll
        for (int ai = 0; ai < 2; ++ai)
#pragma unroll
            for (int m = 0; m < 4; ++m) { bf16_t* rowp = base + (size_t)(row0 + ai * HALF + m * 16) * 1024 + col0;
#pragma unroll
                for (int bj = 0; bj < 2; ++bj) { const f32x4 v0 = acc[ai][bj][m][0] * sc, v1 = acc[ai][bj][m][1] * sc;
                    u32x4 w; w.x = cvt_pk_bf16(v0[0], v0[1]); w.y = cvt_pk_bf16(v0[2], v0[3]); w.z = cvt_pk_bf16(v1[0], v1[1]); w.w = cvt_pk_bf16(v1[2], v1[3]);
                    *(u32x4*)(rowp + bj * HALF) = w;
                    if (t == 1) { float s = (v0[0] * v0[0] + v0[1] * v0[1]) + (v0[2] * v0[2] + v0[3] * v0[3]) + (v1[0] * v1[0] + v1[1] * v1[1]) + (v1[2] * v1[2] + v1[3] * v1[3]);
                        s += __shfl_xor(s, 16); s += __shfl_xor(s, 32); mx[bj] = fmaxf(mx[bj], s); } } }
        if (t == 1) {
#pragma unroll
            for (int bj = 0; bj < 2; ++bj) { float m = mx[bj]; m = fmaxf(m, __shfl_xor(m, 1)); m = fmaxf(m, __shfl_xor(m, 2)); m = fmaxf(m, __shfl_xor(m, 4)); m = fmaxf(m, __shfl_xor(m, 8));
                if (fr == 0 && fq == 0) atomicMax(kn2 + ((u.pm >> 5) * 16 + (colt + bj * HALF) / 64 + (wc >> 1)) * 2 + (wc & 1), __float_as_uint(m)); } }
    } };
struct GroupedOrder {
    const int* tile_e; int nN, nwg, G, c;
    __device__ void init(const int* TILE, int nN_, int G_, int c_) { const int nt = __builtin_amdgcn_readfirstlane(TILE[0]); tile_e = TILE + 16; nN = nN_; nwg = nt * nN_; G = G_; c = c_; }
    __device__ bool next(int i, Unit& u) const {
        const int L = i * G + c; if (L >= nwg) return false;
        int wgid = L; { const int q = nwg / NXCD, r = nwg % NXCD, xcd = wgid % NXCD, off = wgid / NXCD; wgid = (xcd < r ? xcd * (q + 1) : r * (q + 1) + (xcd - r) * q) + off; }
        const int pm = wgid / nN, pn = wgid % nN; const int e = __builtin_amdgcn_readfirstlane(tile_e[pm]);
        u.pm = pm; u.pn = e * nN + pn; return true;
    }
    __device__ __forceinline__ void a_ready(const Unit&) const {}
    __device__ __forceinline__ void done(const Unit&) const {}
};
template <class Epi, class Sched, bool ALIGN_EPI = false, bool SP2 = false, bool GATHER = false, bool FP8 = false>
__device__ __forceinline__ void gemm_phase(PG8_LAS unsigned char* lds, const Gemm g, const Sched& S, const Epi& E, const int* rowtok = nullptr) {
    static_assert(!GATHER || SP2, "GATHER is written for the SP2 loop");
    const int tid = threadIdx.x, wid = __builtin_amdgcn_readfirstlane(tid >> 6), lane = tid & 63, wr = wid >> 2, wc = wid & 3, fr = lane & 15, fq = lane >> 4;
    const int K = g.K, nt = K / BK;
    unsigned voffA[2], voffB[2]; unsigned vA[2][2], nvA[2][2];
#pragma unroll
    for (int i = 0; i < 2; ++i) { int R, C; stage_rc(tid * 16 + i * 8192, R, C); const int Rb = Epi::PERM ? ((R & ~31) + perm32(R & 31)) : R;
        voffA[i] = (unsigned)(R * K + C) * 2u; voffB[i] = (unsigned)(Rb * K + C) * 2u; }
    const unsigned kstep = (unsigned)(BK * 2);
    const unsigned hstep = (unsigned)HALF * K * 2;
    const unsigned tstep = 2 * hstep, r64step = 64u * (unsigned)K * 2u;
    const __amdgpu_buffer_rsrc_t rsA = __builtin_amdgcn_make_buffer_rsrc((void*)g.A, 0, 0x7fffffff, 0x00020000), rsB = __builtin_amdgcn_make_buffer_rsrc((void*)g.Bt, 0, 0x7fffffff, 0x00020000);
    const unsigned ldsw = (unsigned)wid * 1024u;
    const int aoff = lds_byte(wr * 64 + fr, fq * 8), boff = lds_byte(wc * 32 + fr, fq * 8);
#define PG8_SA(b, h) (((b) * 2 + (h)) * HTB)
#define PG8_SB(b, h) ((4 + (b) * 2 + (h)) * HTB)
#define PG8_STAGE_R(rs, bufoff, soff, voff) do { _Pragma("unroll") for (int _i = 0; _i < 2; ++_i)     \
        __builtin_amdgcn_raw_ptr_buffer_load_lds(rs, (PG8_LAS unsigned*)(lds + (bufoff) + ldsw + _i * 8192), 16, (int)(voff)[0], (int)((soff) + _i * r64step), 0, 0); } while (0)
#define PG8_STAGE2(bufoff, soff, v0, v1) do { __builtin_amdgcn_raw_ptr_buffer_load_lds(rsA, (PG8_LAS unsigned*)(lds + (bufoff) + ldsw), 16, (int)(v0), (int)(soff), 0, 0); \
        __builtin_amdgcn_raw_ptr_buffer_load_lds(rsA, (PG8_LAS unsigned*)(lds + (bufoff) + ldsw + 8192), 16, (int)(v1), (int)(soff), 0, 0); } while (0)
#define PG8_STAGE_A(bufoff, h, gbase, nx) do { if constexpr (GATHER) { const unsigned s0_ = (nx) ? nvA[h][0] : vA[h][0], s1_ = (nx) ? nvA[h][1] : vA[h][1]; PG8_STAGE2(bufoff, gbase, s0_, s1_); } \
        else { PG8_STAGE_R(rsA, bufoff, (gbase) + ((h) ? hstep : 0u), voffA); } } while (0)
#define PG8_GATHER_OFFS(dst, un) do { _Pragma("unroll") for (int h_ = 0; h_ < 2; ++h_) _Pragma("unroll") for (int i_ = 0; i_ < 2; ++i_) \
        { int R_, C_; stage_rc(tid * 16 + i_ * 8192, R_, C_); dst[h_][i_] = (unsigned)rowtok[(un).pm * BM + h_ * HALF + R_] * (unsigned)(K * 2) + (unsigned)C_ * 2u; } } while (0)
#define PG8_LDA(dst, b, h) do { _Pragma("unroll") for (int m = 0; m < 4; ++m) _Pragma("unroll") for (int k = 0; k < 2; ++k) dst[m][k] = *(const PG8_LAS bf16x8*)(lds + PG8_SA(b, h) + aoff + m * 2048 + k * 1024); } while (0)
#define PG8_LDB(dst, b, h) do { _Pragma("unroll") for (int n = 0; n < 2; ++n) _Pragma("unroll") for (int k = 0; k < 2; ++k) dst[n][k] = *(const PG8_LAS bf16x8*)(lds + PG8_SB(b, h) + boff + n * 2048 + k * 1024); } while (0)
#define PG8_CAT8(x) __builtin_shufflevector(__builtin_bit_cast(i32x4_t, (x)[0]), __builtin_bit_cast(i32x4_t, (x)[1]), 0, 1, 2, 3, 4, 5, 6, 7)
#define PG8_MMA(ai, bj, At, Bt) do { __builtin_amdgcn_s_setprio(1); _Pragma("unroll") for (int m = 0; m < 4; ++m) _Pragma("unroll") for (int n = 0; n < 2; ++n) { \
        if constexpr (FP8) { acc[ai][bj][m][n] = __builtin_amdgcn_mfma_scale_f32_16x16x128_f8f6f4(PG8_CAT8(Bt[n]), PG8_CAT8(At[m]), acc[ai][bj][m][n], 0, 0, 0, 0, 0, 0); } \
        else { _Pragma("unroll") for (int k = 0; k < 2; ++k) acc[ai][bj][m][n] = __builtin_amdgcn_mfma_f32_16x16x32_bf16(Bt[n][k], At[m][k], acc[ai][bj][m][n], 0, 0, 0); } } \
        __builtin_amdgcn_s_setprio(0); } while (0)
#define PG8_WAIT_V(n) asm volatile("s_waitcnt vmcnt(" #n ")" ::: "memory")
#define PG8_WAIT_L(n) asm volatile("s_waitcnt lgkmcnt(" #n ")" ::: "memory")
#define PG8_BAR __builtin_amdgcn_s_barrier()
#define PG8_SCHED __builtin_amdgcn_sched_barrier(0)
    Unit cur, nxt; int ui = 0;
    if (!S.next(0, cur)) return;
    if constexpr (Epi::MIDK) E.prep(cur, 0, tid);
    f32x4 acc[2][2][4][2];
#pragma unroll
    for (int a = 0; a < 2; ++a)
#pragma unroll
        for (int b = 0; b < 2; ++b)
#pragma unroll
            for (int m = 0; m < 4; ++m)
#pragma unroll
                for (int n = 0; n < 2; ++n) { acc[a][b][m][n] = (f32x4){0.f, 0.f, 0.f, 0.f}; if constexpr (FP8) asm volatile("" : "+v"(acc[a][b][m][n])); }
    bf16x8 At[4][2], B0[2][2], B1[2][2];
    unsigned cA = GATHER ? 0u : (unsigned)cur.pm * tstep; unsigned cB = (unsigned)cur.pn * tstep;
    if constexpr (GATHER) { PG8_GATHER_OFFS(vA, cur); }
    S.a_ready(cur);
    if constexpr (SP2) {
        PG8_STAGE_R(rsB, PG8_SB(0, 0), cB, voffB); PG8_STAGE_R(rsB, PG8_SB(0, 1), cB + hstep, voffB); PG8_STAGE_A(PG8_SA(0, 0), 0, cA, false); PG8_STAGE_A(PG8_SA(0, 1), 1, cA, false);
        if (wr == 1) PG8_BAR;
        PG8_WAIT_V(2); PG8_BAR;
        PG8_STAGE_R(rsB, PG8_SB(1, 0), cB + kstep, voffB); PG8_STAGE_A(PG8_SA(1, 0), 0, cA + kstep, false); PG8_STAGE_R(rsB, PG8_SB(1, 1), cB + hstep + kstep, voffB);
        PG8_WAIT_V(6); PG8_BAR;
    } else {
        PG8_STAGE_R(rsB, PG8_SB(0, 0), cB, voffB); PG8_STAGE_R(rsA, PG8_SA(0, 0), cA, voffA); PG8_STAGE_R(rsB, PG8_SB(0, 1), cB + hstep, voffB); PG8_STAGE_R(rsA, PG8_SA(0, 1), cA + hstep, voffA);
        if (wr == 1) PG8_BAR;
        PG8_WAIT_V(4); PG8_BAR;
        PG8_STAGE_R(rsB, PG8_SB(1, 0), cB + kstep, voffB); PG8_STAGE_R(rsA, PG8_SA(1, 0), cA + kstep, voffA); PG8_STAGE_R(rsB, PG8_SB(1, 1), cB + hstep + kstep, voffB);
        PG8_WAIT_V(6); PG8_BAR;
    }
    for (;;) {
        const bool has_next = S.next(ui + 1, nxt);
        if constexpr (Epi::MIDK) { if (has_next) E.prep(nxt, (ui + 1) & 1, tid); }
        if constexpr (GATHER) { if (has_next) { PG8_GATHER_OFFS(nvA, nxt); } else { _Pragma("unroll") for (int h_ = 0; h_ < 2; ++h_) _Pragma("unroll") for (int i_ = 0; i_ < 2; ++i_) nvA[h_][i_] = vA[h_][i_]; } }
        const unsigned nA = GATHER ? 0u : (has_next ? (unsigned)nxt.pm * tstep : cA); const unsigned nB = has_next ? (unsigned)nxt.pn * tstep : cB;
        for (int t = 0; t < nt; t += 2) {
            const bool last = (t == nt - 2);
            const unsigned a1 = cA + (unsigned)(t + 1) * kstep;
            const unsigned a2 = last ? nA : cA + (unsigned)(t + 2) * kstep; const unsigned b2 = last ? nB : cB + (unsigned)(t + 2) * kstep;
            const unsigned a3 = a2 + kstep; const unsigned b3 = b2 + kstep;
            if (last && has_next) S.a_ready(nxt);
            if constexpr (SP2) {
            PG8_LDB(B0, 0, 0); PG8_LDB(B1, 0, 1); PG8_SCHED; PG8_LDA(At, 0, 0); PG8_STAGE_A(PG8_SA(1, 1), 1, a1, false);
            PG8_WAIT_V(8); PG8_WAIT_L(0); PG8_BAR; PG8_MMA(0, 0, At, B0); PG8_MMA(0, 1, At, B1); PG8_BAR; PG8_SCHED;
            PG8_LDA(At, 0, 1); PG8_STAGE_R(rsB, PG8_SB(0, 0), b2, voffB); PG8_STAGE_R(rsB, PG8_SB(0, 1), b2 + hstep, voffB); PG8_STAGE_A(PG8_SA(0, 0), 0, a2, last);
            PG8_WAIT_V(8); PG8_WAIT_L(0); PG8_BAR; PG8_MMA(1, 0, At, B0); PG8_MMA(1, 1, At, B1); PG8_BAR; PG8_SCHED;
            PG8_LDB(B0, 1, 0); PG8_LDB(B1, 1, 1); PG8_SCHED; PG8_LDA(At, 1, 0); PG8_STAGE_A(PG8_SA(0, 1), 1, a2, last);
            PG8_WAIT_V(8); PG8_WAIT_L(0); PG8_BAR; PG8_MMA(0, 0, At, B0); PG8_MMA(0, 1, At, B1); PG8_BAR; PG8_SCHED;
            PG8_LDA(At, 1, 1); PG8_STAGE_R(rsB, PG8_SB(1, 0), b3, voffB); PG8_STAGE_R(rsB, PG8_SB(1, 1), b3 + hstep, voffB); PG8_STAGE_A(PG8_SA(1, 0), 0, a3, last);
            PG8_WAIT_V(8); PG8_WAIT_L(0); PG8_BAR; PG8_MMA(1, 0, At, B0); PG8_MMA(1, 1, At, B1); PG8_BAR; PG8_SCHED;
            } else {
            PG8_LDB(B0, 0, 0); PG8_SCHED; PG8_LDA(At, 0, 0); PG8_STAGE_R(rsA, PG8_SA(1, 1), a1 + hstep, voffA);
            PG8_WAIT_L(8); PG8_BAR; PG8_WAIT_L(0); PG8_MMA(0, 0, At, B0); PG8_BAR; PG8_SCHED;
            PG8_LDB(B1, 0, 1); PG8_STAGE_R(rsB, PG8_SB(0, 0), b2, voffB);
            PG8_BAR; PG8_WAIT_L(0); PG8_MMA(0, 1, At, B1); PG8_BAR;
            PG8_LDA(At, 0, 1); PG8_STAGE_R(rsA, PG8_SA(0, 0), a2, voffA);
            PG8_BAR; PG8_WAIT_L(0); PG8_MMA(1, 0, At, B0); PG8_BAR; PG8_SCHED;
            PG8_STAGE_R(rsB, PG8_SB(0, 1), b2 + hstep, voffB);
            PG8_WAIT_V(6); PG8_BAR; PG8_MMA(1, 1, At, B1); PG8_BAR;
            PG8_LDB(B0, 1, 0); PG8_SCHED; PG8_LDA(At, 1, 0); PG8_STAGE_R(rsA, PG8_SA(0, 1), a2 + hstep, voffA);
            PG8_WAIT_L(8); PG8_BAR; PG8_WAIT_L(0); PG8_MMA(0, 0, At, B0); PG8_BAR; PG8_SCHED;
            PG8_LDB(B1, 1, 1); PG8_STAGE_R(rsB, PG8_SB(1, 0), b3, voffB);
            PG8_BAR; PG8_WAIT_L(0); PG8_MMA(0, 1, At, B1); PG8_BAR;
            PG8_LDA(At, 1, 1); PG8_STAGE_R(rsA, PG8_SA(1, 0), a3, voffA);
            PG8_BAR; PG8_WAIT_L(0); PG8_MMA(1, 0, At, B0); PG8_BAR; PG8_SCHED;
            PG8_STAGE_R(rsB, PG8_SB(1, 1), b3 + hstep, voffB);
            PG8_WAIT_V(6); PG8_BAR; PG8_MMA(1, 1, At, B1); PG8_BAR;
            }
            if constexpr (Epi::MIDK) { if (t == nt / 2 - 2) E.midk(acc, ui & 1, wr, fr); }
        }
        if constexpr (ALIGN_EPI) { if (wr == 0) PG8_BAR; }
        int l_e; asm volatile("v_mbcnt_lo_u32_b32 %0, -1, 0\n\tv_mbcnt_hi_u32_b32 %0, -1, %0" : "=v"(l_e)); const int fr_e = l_e & 15, fq_e = l_e >> 4;
        if constexpr (Epi::MIDK) { E.epi(acc, cur, ui & 1, wr, wc, fr_e, fq_e); S.done(cur); }
        else if constexpr (!Epi::AFTER_DRAIN) { E(acc, cur, wr, wc, fr_e, fq_e); S.done(cur); }
        if (!has_next) break;
#pragma unroll
        for (int a = 0; a < 2; ++a)
#pragma unroll
            for (int b = 0; b < 2; ++b)
#pragma unroll
                for (int m = 0; m < 4; ++m)
#pragma unroll
                    for (int n = 0; n < 2; ++n) { acc[a][b][m][n] = (f32x4){0.f, 0.f, 0.f, 0.f}; if constexpr (FP8) asm volatile("" : "+v"(acc[a][b][m][n])); }
        cur = nxt; cA = nA; cB = nB; ++ui;
        if constexpr (GATHER) { _Pragma("unroll") for (int h_ = 0; h_ < 2; ++h_) _Pragma("unroll") for (int i_ = 0; i_ < 2; ++i_) vA[h_][i_] = nvA[h_][i_]; }
        if constexpr (ALIGN_EPI) { if (wr == 1) PG8_BAR; }
    }
    PG8_WAIT_V(0);
    if constexpr (!ALIGN_EPI) { if (wr == 0) PG8_BAR; }
    PG8_BAR;
    if constexpr (Epi::AFTER_DRAIN) { E.fused(acc, cur, wr, wc, fr, fq, lds, wid, lane); S.done(cur); }
#undef PG8_SA
#undef PG8_SB
#undef PG8_STAGE_R
#undef PG8_STAGE2
#undef PG8_STAGE_A
#undef PG8_GATHER_OFFS
#undef PG8_LDA
#undef PG8_LDB
#undef PG8_MMA
#undef PG8_CAT8
#undef PG8_WAIT_V
#undef PG8_WAIT_L
#undef PG8_BAR
#undef PG8_SCHED
}
}

namespace att {
typedef short bf16x8 __attribute__((ext_vector_type(8)));
typedef short s16x4 __attribute__((ext_vector_type(4)));
typedef float f32x16 __attribute__((ext_vector_type(16)));
typedef float f32x4 __attribute__((ext_vector_type(4)));
typedef unsigned u32x4 __attribute__((ext_vector_type(4)));
typedef unsigned u32x2 __attribute__((ext_vector_type(2)));
typedef short v4i16_t __attribute__((ext_vector_type(4)));
typedef __attribute__((address_space(3))) const char* lds_cptr;
constexpr int DM = 1024, SLOTB = 8192;
constexpr int NSLOT = 8, DIST = 4;
constexpr int L_K = 0, L_V = NSLOT * SLOTB, L_B = 2 * NSLOT * SLOTB, L_DONE = L_B + NSLOT * 256, L_BYTES = L_DONE + 64;
constexpr float FOX_THR = 40.f, SB_THR = 32.f;
__device__ __forceinline__ int crow(int r, int hi) { return (r & 3) + 8 * (r >> 2) + 4 * hi; }
__device__ __forceinline__ void glds16(const void* gsrc, unsigned lds_dst) { unsigned keep;
    asm volatile("s_mov_b32 %0, m0\n\ts_mov_b32 m0, %2\n\ts_nop 0\n\tglobal_load_lds_dwordx4 %1, off\n\ts_mov_b32 m0, %0" : "=&s"(keep) : "v"(gsrc), "s"(lds_dst) : "memory"); }
__device__ __forceinline__ void glds4(const void* gsrc, unsigned lds_dst) { unsigned keep;
    asm volatile("s_mov_b32 %0, m0\n\ts_mov_b32 m0, %2\n\ts_nop 0\n\tglobal_load_lds_dword %1, off\n\ts_mov_b32 m0, %0" : "=&s"(keep) : "v"(gsrc), "s"(lds_dst) : "memory"); }
typedef float f32x2_t __attribute__((ext_vector_type(2))); typedef __bf16 bf16x2_t __attribute__((ext_vector_type(2)));
__device__ __forceinline__ unsigned cvtpk(float lo, float hi) { f32x2_t v = {lo, hi}; bf16x2_t b = __builtin_convertvector(v, bf16x2_t); return __builtin_bit_cast(unsigned, b); }
__device__ __forceinline__ s16x4 vtr(lds_cptr p) { return __builtin_bit_cast(s16x4, __builtin_amdgcn_ds_read_tr16_b64_v4i16((__attribute__((address_space(3))) v4i16_t*)p)); }
#define ATT_WAIT_BAR() asm volatile("s_waitcnt vmcnt(0) lgkmcnt(0)\n\ts_barrier" ::: "memory")
#define ATT_BAR() asm volatile("s_barrier" ::: "memory")
#define ATT_LBAR() asm volatile("s_waitcnt lgkmcnt(0)\n\ts_barrier" ::: "memory")
#define ATT_WAITV_BAR(n) asm volatile("s_waitcnt vmcnt(" #n ") lgkmcnt(0)\n\ts_barrier" ::: "memory")
__device__ __forceinline__ float max3f(float a, float b, float c) { float r; asm("v_max3_f32 %0, %1, %2, %3" : "=v"(r) : "v"(a), "v"(b), "v"(c)); return r; }

constexpr int G_SLOTS = 4;
constexpr int G_K = 0, G_V = G_SLOTS * SLOTB, G_B = 2 * G_SLOTS * SLOTB, G_DONE = G_B + G_SLOTS * 256, G_ARR = G_DONE + 64, G_BYTES = G_ARR + 64;
typedef volatile __attribute__((address_space(3))) unsigned* lds_vu32;
__device__ __forceinline__ void grp_barrier(lds_vu32 arr, unsigned& epoch, int wid, int lane) {
    ++epoch;
    if (lane == 0) arr[wid] = epoch;
    for (;;) { const unsigned v = (lane < 4) ? arr[lane] : epoch; if (__all(v >= epoch)) break; __builtin_amdgcn_s_sleep(0); }
    asm volatile("" ::: "memory");
}
#define G_WAITV(n) asm volatile("s_waitcnt vmcnt(" #n ") lgkmcnt(0)" ::: "memory")
template <bool FOX, bool PRUNE>
__device__ __forceinline__ void attn_unit4(int b, int h16, int qb, const bf16* QO, bf16* F_O, const bf16* __restrict__ K, const bf16* __restrict__ V, float* SSQ, const float* CLrow, float KN, char* shm, unsigned& epoch) {
    const int tid = threadIdx.x, lane = tid & 63, r32 = lane & 31, hi = lane >> 5; const int wid = __builtin_amdgcn_readfirstlane((tid >> 6) & 3);
    const long rowbase = (long)b * SEQ; const int q0 = qb * 128;
    const bf16* Qw = QO + (rowbase + q0 + wid * 32) * DM + h16 * 64;
    const bf16* Kh = K + rowbase * DM + h16 * 64; const bf16* Vh = V + rowbase * DM + h16 * 64;
    const unsigned lds0 = (unsigned)(uintptr_t)shm;
    const bf16* ksrc = Kh + (long)(8 * wid + (lane >> 3)) * DM + (((lane & 7) ^ (lane >> 3)) * 8);
    const bf16* vsrc = Vh + (long)(16 * wid + (lane >> 2)) * DM + (lane & 3) * 8;
    const unsigned kdst = lds0 + G_K + wid * 1024, vdst = lds0 + G_V + wid * 1024, bdst = lds0 + G_B;
    const lds_cptr shm3 = (lds_cptr)shm;
    const lds_cptr kp0 = shm3 + G_K + r32 * 128; const int kx = ((r32 & 7) ^ hi) << 4;
    const lds_cptr vp0 = shm3 + G_V + ((lane >> 4) & 1) * 32 + (lane & 3) * 8 + (4 * hi + ((lane & 15) >> 2)) * 64;
    volatile __attribute__((address_space(3))) int* done_at = (volatile __attribute__((address_space(3))) int*)(shm3 + G_DONE);
    lds_vu32 arr = (lds_vu32)(shm3 + G_ARR);
    const int NT = (q0 + 128) / 64;
#define G_DMA(t, slot) do { glds16(ksrc + (long)(t) * 64 * DM, (unsigned)__builtin_amdgcn_readfirstlane(kdst + (slot) * SLOTB)); glds16(ksrc + (long)((t) * 64 + 32) * DM, (unsigned)__builtin_amdgcn_readfirstlane(kdst + 4096 + (slot) * SLOTB)); \
        glds16(vsrc + (long)(t) * 64 * DM, (unsigned)__builtin_amdgcn_readfirstlane(vdst + (slot) * SLOTB)); glds16(vsrc + (long)(t) * 64 * DM + 32, (unsigned)__builtin_amdgcn_readfirstlane(vdst + 4096 + (slot) * SLOTB)); \
        if (FOX) glds4(CLrow + (t) * 64 + lane, (unsigned)__builtin_amdgcn_readfirstlane(bdst + (slot) * 256)); } while (0)
    bf16x8 qr[4];
#pragma unroll
    for (int d0 = 0; d0 < 4; ++d0) qr[d0] = *reinterpret_cast<const bf16x8*>(&Qw[(long)r32 * DM + d0 * 16 + hi * 8]);
    float qn = 0.f;
    if (FOX && PRUNE) {
#pragma unroll
        for (int d0 = 0; d0 < 4; ++d0)
#pragma unroll
            for (int j = 0; j < 8; ++j) { const float v = __builtin_bit_cast(float, (unsigned)(unsigned short)qr[d0][j] << 16); qn += v * v; }
        qn += __shfl_xor(qn, 32); qn = sqrtf(qn) * KN;
    }
    const float clref = FOX ? CLrow[q0 + wid * 32] : 0.f;
    const int qrel = wid * 32 + r32;
    asm volatile("" :: "v"(qr[0]), "v"(qr[1]), "v"(qr[2]), "v"(qr[3]), "v"(clref), "v"(qn));
    G_WAITV(0); grp_barrier(arr, epoch, wid, lane);
    if (lane == 0) done_at[wid] = 0x7fffffff;
    G_DMA(NT - 1, 0); G_DMA(NT - 2, 1); if (NT >= 3) G_DMA(NT - 3, 2);
    f32x16 o0 = {}, o1 = {}, lacc = {};
    float mref = 0.f, R = 0.f;
    bool mydone = false, posted = false, first = true;
    bf16x8 U0, U1, ONES;
#pragma unroll
    for (int j = 0; j < 8; ++j) { const int kk = 8 * (j >> 2) + 4 * hi + (j & 3); U0[j] = (kk > r32) ? (short)0x3f80 : (short)0; U1[j] = (16 + kk > r32) ? (short)0x3f80 : (short)0; ONES[j] = (short)0x3f80; }
    for (int i = 0;; ++i) {
        const int t = NT - 1 - i, slot = i & (G_SLOTS - 1);
        if (t < 0) break;
        { const int ahead = t < 2 ? t : 2;
          if (FOX) { if (ahead == 2) G_WAITV(10); else if (ahead == 1) G_WAITV(5); else G_WAITV(0); }
          else     { if (ahead == 2) G_WAITV(8); else if (ahead == 1) G_WAITV(4); else G_WAITV(0); } }
        grp_barrier(arr, epoch, wid, lane);
        if (i > 0) { const int da = done_at[lane & 3]; if (__all(da <= i - 1)) break; }
        if (t >= 3) G_DMA(t - 3, (i + 3) & (G_SLOTS - 1));
        const int jb = t - (NT - 2);
        if (!mydone && !(jb >= 0 && 2 * jb > wid)) {
            const lds_cptr kp = kp0 + slot * SLOTB; const lds_cptr vp = vp0 + slot * SLOTB;
            bf16x8 kf[8];
#pragma unroll
            for (int d0 = 0; d0 < 4; ++d0) { const int ko = kx ^ (d0 << 5); kf[2 * d0] = *(const __attribute__((address_space(3))) bf16x8*)(kp + ko); kf[2 * d0 + 1] = *(const __attribute__((address_space(3))) bf16x8*)(kp + ko + 4096); }
            const bool need_mask = __builtin_amdgcn_readfirstlane((int)(jb >= 0 && 64 * jb + 63 > 32 * wid)) != 0;
            f32x16 p0, p1; float bias00 = 0.f;
            if (FOX) {
                const __attribute__((address_space(3))) f32x4* bp = (const __attribute__((address_space(3))) f32x4*)(shm3 + G_B + slot * 256);
                const float cm = clref - mref;
#pragma unroll
                for (int g = 0; g < 4; ++g) { const f32x4 c0 = bp[2 * g + hi], c1 = bp[8 + 2 * g + hi];
#pragma unroll
                    for (int e = 0; e < 4; ++e) { p0[4 * g + e] = cm - c0[e]; p1[4 * g + e] = cm - c1[e]; } }
                bias00 = clref - bp[0][0];
            } else { p0 = f32x16{}; p1 = f32x16{}; }
#pragma unroll
            for (int d0 = 0; d0 < 4; ++d0) { p0 = __builtin_amdgcn_mfma_f32_32x32x16_bf16(kf[2 * d0], qr[d0], p0, 0, 0, 0); p1 = __builtin_amdgcn_mfma_f32_32x32x16_bf16(kf[2 * d0 + 1], qr[d0], p1, 0, 0, 0); }
            s16x4 vlo[8], vhi[8];
#pragma unroll
            for (int q = 0; q < 8; ++q) { vlo[q] = vtr(vp + ((q >> 2) * 4096 + (q & 3) * 1024)); vhi[q] = vtr(vp + ((q >> 2) * 4096 + (q & 3) * 1024 + 512)); }
            if (FOX) asm volatile("s_nop 15\n\ts_nop 7" : "+v"(p0), "+v"(p1));
            if (FOX) {
                if (need_mask) { asm volatile("" ::: "memory");
#pragma unroll
                    for (int r = 0; r < 16; ++r) { const int kv = 64 * jb + crow(r, hi); if (kv > qrel) p0[r] = -INFINITY; if (kv + 32 > qrel) p1[r] = -INFINITY; } }
                float ma = max3f(p0[0], p1[0], p0[1]), mb = max3f(p1[1], p0[2], p1[2]);
#pragma unroll
                for (int r = 3; r < 15; r += 2) { ma = max3f(ma, p0[r], p1[r]); mb = max3f(mb, p0[r + 1], p1[r + 1]); }
                ma = max3f(ma, p0[15], p1[15]);
                float mt = max3f(ma, mb, mb); mt = max3f(mt, __shfl_xor(mt, 32), mt);
                if (first || __any(mt > 0.f)) {
                    const float d = first ? mt : fmaxf(mt, 0.f); mref += d;
                    if (!first) { const float alpha = __builtin_amdgcn_exp2f(-d);
#pragma unroll
                        for (int r = 0; r < 16; ++r) { o0[r] *= alpha; o1[r] *= alpha; }
                        lacc[0] *= alpha; }
#pragma unroll
                    for (int r = 0; r < 16; ++r) { p0[r] -= d; p1[r] -= d; }
                    first = false;
                }
#pragma unroll
                for (int r = 0; r < 16; ++r) { p0[r] = __builtin_amdgcn_exp2f(p0[r]); p1[r] = __builtin_amdgcn_exp2f(p1[r]); }
                if (t == 0) mydone = true;
                else if (PRUNE) mydone = __all(qn + bias00 - mref < -FOX_THR);
            } else {
                f32x16 x0, x1;
#pragma unroll
                for (int r = 0; r < 16; ++r) {
                    { const float z = p0[r]; const float sp = __builtin_amdgcn_logf(1.f + __builtin_amdgcn_exp2f(-fabsf(z))); const float lb = fminf(z, 0.f) - sp; p0[r] = lb; x0[r] = lb - z; }
                    { const float z = p1[r]; const float sp = __builtin_amdgcn_logf(1.f + __builtin_amdgcn_exp2f(-fabsf(z))); const float lb = fminf(z, 0.f) - sp; p1[r] = lb; x1[r] = lb - z; } }
                if (need_mask) { asm volatile("" ::: "memory");
#pragma unroll
                    for (int r = 0; r < 16; ++r) { const int kv = 64 * jb + crow(r, hi); if (kv >= qrel) { p0[r] = -INFINITY; x0[r] = 0.f; } if (kv + 32 >= qrel) { p1[r] = -INFINITY; x1[r] = 0.f; } } }
                u32x4 xw0, xw1, xw2, xw3;
                xw0 = (u32x4){cvtpk(x0[0], x0[1]), cvtpk(x0[2], x0[3]), cvtpk(x0[4], x0[5]), cvtpk(x0[6], x0[7])}; xw1 = (u32x4){cvtpk(x0[8], x0[9]), cvtpk(x0[10], x0[11]), cvtpk(x0[12], x0[13]), cvtpk(x0[14], x0[15])};
                xw2 = (u32x4){cvtpk(x1[0], x1[1]), cvtpk(x1[2], x1[3]), cvtpk(x1[4], x1[5]), cvtpk(x1[6], x1[7])}; xw3 = (u32x4){cvtpk(x1[8], x1[9]), cvtpk(x1[10], x1[11]), cvtpk(x1[12], x1[13]), cvtpk(x1[14], x1[15])};
                p1 = __builtin_amdgcn_mfma_f32_32x32x16_bf16(U0, __builtin_bit_cast(bf16x8, xw2), p1, 0, 0, 0);
                p1 = __builtin_amdgcn_mfma_f32_32x32x16_bf16(U1, __builtin_bit_cast(bf16x8, xw3), p1, 0, 0, 0);
                p0 = __builtin_amdgcn_mfma_f32_32x32x16_bf16(U0, __builtin_bit_cast(bf16x8, xw0), p0, 0, 0, 0);
                p0 = __builtin_amdgcn_mfma_f32_32x32x16_bf16(U1, __builtin_bit_cast(bf16x8, xw1), p0, 0, 0, 0);
                p0 = __builtin_amdgcn_mfma_f32_32x32x16_bf16(ONES, __builtin_bit_cast(bf16x8, xw2), p0, 0, 0, 0);
                p0 = __builtin_amdgcn_mfma_f32_32x32x16_bf16(ONES, __builtin_bit_cast(bf16x8, xw3), p0, 0, 0, 0);
                f32x16 tt = __builtin_amdgcn_mfma_f32_32x32x16_bf16(ONES, __builtin_bit_cast(bf16x8, xw0), f32x16{}, 0, 0, 0);
                tt = __builtin_amdgcn_mfma_f32_32x32x16_bf16(ONES, __builtin_bit_cast(bf16x8, xw1), tt, 0, 0, 0);
                tt = __builtin_amdgcn_mfma_f32_32x32x16_bf16(ONES, __builtin_bit_cast(bf16x8, xw2), tt, 0, 0, 0);
                tt = __builtin_amdgcn_mfma_f32_32x32x16_bf16(ONES, __builtin_bit_cast(bf16x8, xw3), tt, 0, 0, 0);
#pragma unroll
                for (int r = 0; r < 16; ++r) { p0[r] = __builtin_amdgcn_exp2f(p0[r] + R); p1[r] = __builtin_amdgcn_exp2f(p1[r] + R); }
                R += tt[0];
                if (t == 0) mydone = true;
                else if (PRUNE) mydone = __all(R < -SB_THR);
            }
            u32x4 pw0, pw1, pw2, pw3;
            pw0 = (u32x4){cvtpk(p0[0], p0[1]), cvtpk(p0[2], p0[3]), cvtpk(p0[4], p0[5]), cvtpk(p0[6], p0[7])}; pw1 = (u32x4){cvtpk(p0[8], p0[9]), cvtpk(p0[10], p0[11]), cvtpk(p0[12], p0[13]), cvtpk(p0[14], p0[15])};
            pw2 = (u32x4){cvtpk(p1[0], p1[1]), cvtpk(p1[2], p1[3]), cvtpk(p1[4], p1[5]), cvtpk(p1[6], p1[7])}; pw3 = (u32x4){cvtpk(p1[8], p1[9]), cvtpk(p1[10], p1[11]), cvtpk(p1[12], p1[13]), cvtpk(p1[14], p1[15])};
#define G_PV(OACC, DH, KS, PW) do { const bf16x8 vf_ = (bf16x8){vlo[(DH) * 4 + (KS)][0], vlo[(DH) * 4 + (KS)][1], vlo[(DH) * 4 + (KS)][2], vlo[(DH) * 4 + (KS)][3], vhi[(DH) * 4 + (KS)][0], vhi[(DH) * 4 + (KS)][1], vhi[(DH) * 4 + (KS)][2], vhi[(DH) * 4 + (KS)][3]}; \
                OACC = __builtin_amdgcn_mfma_f32_32x32x16_bf16(vf_, __builtin_bit_cast(bf16x8, PW), OACC, 0, 0, 0); } while (0)
            G_PV(o0, 0, 0, pw0); G_PV(o1, 1, 0, pw0); G_PV(o0, 0, 1, pw1); G_PV(o1, 1, 1, pw1);
            G_PV(o0, 0, 2, pw2); G_PV(o1, 1, 2, pw2); G_PV(o0, 0, 3, pw3); G_PV(o1, 1, 3, pw3);
#undef G_PV
            if (FOX) { lacc = __builtin_amdgcn_mfma_f32_32x32x16_bf16(ONES, __builtin_bit_cast(bf16x8, pw0), lacc, 0, 0, 0); lacc = __builtin_amdgcn_mfma_f32_32x32x16_bf16(ONES, __builtin_bit_cast(bf16x8, pw1), lacc, 0, 0, 0);
                       lacc = __builtin_amdgcn_mfma_f32_32x32x16_bf16(ONES, __builtin_bit_cast(bf16x8, pw2), lacc, 0, 0, 0); lacc = __builtin_amdgcn_mfma_f32_32x32x16_bf16(ONES, __builtin_bit_cast(bf16x8, pw3), lacc, 0, 0, 0); }
        }
        if (t == 0) mydone = true;
        if (mydone && !posted) { if (lane == 0) done_at[wid] = i; posted = true; }
    }
#undef G_DMA
    float inv = 1.f;
    if (FOX) inv = 1.f / lacc[0];
    float ssq = 0.f;
#pragma unroll
    for (int r = 0; r < 16; ++r) { o0[r] *= inv; o1[r] *= inv; ssq += o0[r] * o0[r] + o1[r] * o1[r]; }
    ssq += __shfl_xor(ssq, 32);
    if (hi == 0) SSQ[(size_t)(rowbase + q0 + qrel) * 16 + h16] = ssq;
    bf16* orow = F_O + (rowbase + q0 + wid * 32 + r32) * DM + h16 * 64;
#pragma unroll
    for (int g = 0; g < 4; ++g) {
        u32x2 w0 = {cvtpk(o0[4 * g], o0[4 * g + 1]), cvtpk(o0[4 * g + 2], o0[4 * g + 3])}, w1 = {cvtpk(o1[4 * g], o1[4 * g + 1]), cvtpk(o1[4 * g + 2], o1[4 * g + 3])};
        *(u32x2*)(orow + 8 * g + 4 * hi) = w0; *(u32x2*)(orow + 32 + 8 * g + 4 * hi) = w1; }
}
#undef G_WAITV
}

#define XB_TMO      128
#define XB_XCNT(j)  (256  + 64 * (j))
#define XB_XSUB(j)  (1280 + 64 * (j))
#define XB_XGEN(j)  (2304 + 64 * (j))
#define XB_TOP      3328
#define XB_TOPGEN   3392
#define XCD_BAR_WORDS 3456
#define XB_SPIN_CAP (1u << 21)
__device__ __forceinline__ unsigned xb_ld(unsigned* p)              { return __hip_atomic_load(p, __ATOMIC_RELAXED, __HIP_MEMORY_SCOPE_AGENT); }
__device__ __forceinline__ unsigned xb_add(unsigned* p, unsigned v) { return __hip_atomic_fetch_add(p, v, __ATOMIC_RELAXED, __HIP_MEMORY_SCOPE_AGENT); }
__device__ __forceinline__ unsigned xb_xcc_id() { return (unsigned)__builtin_amdgcn_s_getreg((3 << 11) | 20) & 0xFu; }
#define XB_SPIN(cond, bar) do { unsigned _sp = 0; while (cond) { __builtin_amdgcn_s_sleep(1); \
    if ((++_sp & 255u) == 0u) { if (xb_ld(&(bar)[XB_TMO])) break; if (_sp > XB_SPIN_CAP) { atomicAdd(&(bar)[XB_TMO], 1u); break; } } } } while (0)
struct XcdBarrier { unsigned* bar; unsigned x; volatile LAS unsigned* st; };
__device__ __forceinline__ XcdBarrier xcd_barrier_post(unsigned* bar, volatile LAS unsigned* st) {
    XcdBarrier b; b.bar = bar; b.x = xb_xcc_id(); b.st = st;
    if (threadIdx.x == 0) (void)xb_add(&bar[XB_XCNT(b.x)], 1u);
    return b;
}
__device__ __forceinline__ void xcd_barrier_complete(unsigned* bar, unsigned x, unsigned& nloc, unsigned& nx) {
    const unsigned G = gridDim.x * gridDim.y * gridDim.z;
    unsigned sum, cnt, mine, sp = 0u;
    for (;;) {
        sum = 0u; cnt = 0u; mine = 0u;
#pragma unroll
        for (unsigned j = 0; j < 16; ++j) { const unsigned c = xb_ld(&bar[XB_XCNT(j)]); sum += c; cnt += (c > 0u) ? 1u : 0u; mine = (j == x) ? c : mine; }
        if (sum == G) break;
        __builtin_amdgcn_s_sleep(1);
        if ((++sp & 255u) == 0u) { if (xb_ld(&bar[XB_TMO])) break; if (sp > XB_SPIN_CAP) { atomicAdd(&bar[XB_TMO], 1u); break; } }
    }
    nloc = mine > 0u ? mine : 1u; nx = cnt > 0u ? cnt : 1u;
}
__device__ __forceinline__ void xcd_barrier(const XcdBarrier& b) {
    asm volatile("s_waitcnt vmcnt(0)" ::: "memory");
    __syncthreads();
    if (threadIdx.x == 0) {
        unsigned* bar = b.bar;
        __builtin_amdgcn_s_waitcnt(0);
        unsigned nloc = b.st[0], nx = b.st[1];
        if (nloc == 0u) { xcd_barrier_complete(bar, b.x, nloc, nx); b.st[0] = nloc; b.st[1] = nx; }
        const unsigned old = xb_add(&bar[XB_XSUB(b.x)], 1u);
        const unsigned gen = old / nloc;
        if (old + 1u == (gen + 1u) * nloc) {
            __builtin_amdgcn_fence(__ATOMIC_RELEASE, "agent");
            asm volatile("s_waitcnt vmcnt(0)" ::: "memory");
            const unsigned og = xb_add(&bar[XB_TOP], 1u);
            const unsigned tg = og / nx;
            if (og + 1u == (tg + 1u) * nx) xb_add(&bar[XB_TOPGEN], 1u);
            else XB_SPIN(xb_ld(&bar[XB_TOPGEN]) == tg, bar);
            __builtin_amdgcn_fence(__ATOMIC_ACQUIRE, "agent");
            xb_add(&bar[XB_XGEN(b.x)], 1u);
            asm volatile("s_waitcnt vmcnt(0)" ::: "memory");
        } else {
            XB_SPIN(xb_ld(&bar[XB_XGEN(b.x)]) == gen, bar);
            __builtin_amdgcn_fence(__ATOMIC_ACQUIRE, "agent");
            asm volatile("s_waitcnt vmcnt(0)" ::: "memory");
        }
    }
    __syncthreads();
}

struct Args { const float* in[15]; float* out; unsigned char* ws; int ph_lo, ph_hi; };
__device__ __forceinline__ int hw_lane() { return (int)__builtin_amdgcn_mbcnt_hi(~0u, __builtin_amdgcn_mbcnt_lo(~0u, 0u)); }
struct Frame {
    LAS unsigned char* lds; int tid, wave, G, bid;
    const float *x, *g_attn, *w_in, *b_forget, *g_fox, *g_sb, *w_out, *g_ffn, *w_router, *b_router, *w_gu, *b_gu, *w_d, *b_d, *g_final;
    float* out; unsigned char* ws;
};

typedef float f32x2_g __attribute__((ext_vector_type(2))); typedef __bf16 bf16x2_g __attribute__((ext_vector_type(2)));
__device__ __forceinline__ unsigned cvtpk2(float lo, float hi) { f32x2_g v = {lo, hi}; bf16x2_g r = __builtin_convertvector(v, bf16x2_g); return __builtin_bit_cast(unsigned, r); }
__device__ __forceinline__ void transpose_item(const float* W, int ldw, int K, bf16* WT, int item, int nblk, LAS unsigned* scr, int lane, const float* ks = nullptr, const float* ks2 = nullptr) {
    const int kb = item / nblk, nb = item % nblk, k0 = 64 * kb, n0 = 64 * nb, ng = lane & 15, kp = lane >> 4;
    f32x4 a[8], b[8];
#pragma unroll
    for (int i = 0; i < 8; ++i) { const float* p = W + (size_t)(k0 + 8 * i + 2 * kp) * ldw + n0 + 4 * ng; a[i] = __builtin_nontemporal_load((const f32x4*)p); b[i] = __builtin_nontemporal_load((const f32x4*)(p + ldw)); }
    if (ks) { const float* kq = (k0 < 512) ? ks + k0 : ks2 + (k0 - 512);
#pragma unroll
        for (int i = 0; i < 8; ++i) { a[i] = a[i] * kq[8 * i + 2 * kp]; b[i] = b[i] * kq[8 * i + 2 * kp + 1]; } }
#pragma unroll
    for (int i = 0; i < 8; ++i)
#pragma unroll
        for (int j = 0; j < 4; ++j) scr[(4 * ng + j) * 34 + 4 * i + kp] = cvtpk2(a[i][j], b[i][j]);
    LDS_WAIT(); asm volatile("" ::: "memory");
    const int c = lane & 7, rr = lane >> 3;
#pragma unroll
    for (int g = 0; g < 8; ++g) { const int n = 8 * g + rr; const v2u lo = *(const LAS v2u*)(scr + n * 34 + 4 * c), hi = *(const LAS v2u*)(scr + n * 34 + 4 * c + 2);
        *(GAS v4u*)(WT + (size_t)(n0 + n) * K + k0 + 8 * c) = (v4u){lo.x, lo.y, hi.x, hi.y}; }
    LDS_WAIT(); asm volatile("" ::: "memory");
}
__device__ __forceinline__ void transpose_item_fp8(const float* W, int ldw, int K, unsigned char* WT, int item, int nblk, LAS unsigned* scr, int lane, float scale) {
    const int kb = item / nblk, nb = item % nblk, k0 = 128 * kb, n0 = 32 * nb, ng = lane & 7, kq = lane >> 3;
    f32x4 r[4][4];
#pragma unroll
    for (int i = 0; i < 4; ++i)
#pragma unroll
        for (int q = 0; q < 4; ++q) r[i][q] = __builtin_nontemporal_load((const f32x4*)(W + (size_t)(k0 + 32 * i + 4 * kq + q) * ldw + n0 + 4 * ng));
#pragma unroll
    for (int i = 0; i < 4; ++i)
#pragma unroll
        for (int j = 0; j < 4; ++j) scr[(4 * ng + j) * 34 + 8 * i + kq] = pg8::cvt4_fp8(r[i][0][j] * scale, r[i][1][j] * scale, r[i][2][j] * scale, r[i][3][j] * scale);
    LDS_WAIT(); asm volatile("" ::: "memory");
    const int c = lane & 7, rr = lane >> 3;
#pragma unroll
    for (int g = 0; g < 4; ++g) { const int n = rr + 8 * g; const v2u lo = *(const LAS v2u*)(scr + n * 34 + 4 * c), hi = *(const LAS v2u*)(scr + n * 34 + 4 * c + 2);
        *(GAS v4u*)(WT + (size_t)(n0 + n) * K + k0 + 16 * c) = (v4u){lo.x, lo.y, hi.x, hi.y}; }
    LDS_WAIT(); asm volatile("" ::: "memory");
}
__device__ __forceinline__ void p0_prologue(Frame& F) {
    LAS unsigned* scr = (LAS unsigned*)(F.lds + F.wave * 16384);
    const int gw = F.bid * NWAVES + F.wave, NGW = F.G * NWAVES;
    bf16* Win_t = (bf16*)(F.ws + WS_WIN); bf16* Wout_t = (bf16*)(F.ws + WS_WOUT); bf16* Wgu_t = (bf16*)(F.ws + WS_WGU); bf16* Wd_t = (bf16*)(F.ws + WS_WD);
    constexpr int I_IN = 16 * 8, I_OUT = 16 * 16, I_GU = 8 * 64, I_D = 8 * 32;
    constexpr int NITEMS = 6 * I_IN + I_OUT;
    for (int it = gw; it < NITEMS; it += NGW) {
        int r = it;
        if (r < 6 * I_IN) { const int seg = r / I_IN; r -= seg * I_IN;
            const int src = (seg == 0) ? 0 : (seg == 1) ? 1544 : (seg == 2) ? 512 : (seg == 3) ? 2056 : (seg == 4) ? 1024 : 2568;
            transpose_item(F.w_in + src, INC, D, Win_t + (size_t)seg * 512 * D, r, 8, scr, hw_lane()); continue; }
        r -= 6 * I_IN;
        transpose_item(F.w_out, D, D, Wout_t, r, 16, scr, hw_lane(), F.g_fox, F.g_sb);
    }
    __syncthreads();
    LAS float* Wf = (LAS float*)F.lds;
    for (int i = F.tid; i < D * 8; i += NTHR) Wf[i] = F.w_in[(size_t)(i >> 3) * INC + 1536 + (i & 7)];
    __syncthreads();
    bf16* XN = (bf16*)(F.ws + WS_XN); float* LOGF = (float*)(F.ws + WS_LOGF);
    { const int ln = hw_lane();
      const float bfg = F.b_forget[ln & 7];
      f32x4 gq[4], v[4], nv[4];
#pragma unroll
      for (int j = 0; j < 4; ++j) { gq[j] = *((const GAS f32x4*)F.g_attn + ln + 64 * j); nv[j] = (f32x4){0.f, 0.f, 0.f, 0.f}; }
      if (gw < M) { const GAS f32x4* xr = (const GAS f32x4*)(F.x + (size_t)gw * D) + ln;
#pragma unroll
          for (int j = 0; j < 4; ++j) v[j] = xr[64 * j]; }
      float s = 0.f;
#pragma unroll
      for (int j = 0; j < 4; ++j) s += (v[j].x * v[j].x + v[j].y * v[j].y) + (v[j].z * v[j].z + v[j].w * v[j].w);
      for (int m = gw; m < M; m += NGW) {
        { const int mn = (m + NGW < M) ? m + NGW : m;
          const GAS f32x4* xr = (const GAS f32x4*)(F.x + (size_t)mn * D) + ln;
#pragma unroll
          for (int j = 0; j < 4; ++j) nv[j] = xr[64 * j]; }
        const float rs = 1.0f / sqrtf(wave_sum(s) * (1.f / D) + EPS);
        float fa[8];
#pragma unroll
        for (int h = 0; h < 8; ++h) fa[h] = 0.f;
        GAS unsigned long long* o8 = (GAS unsigned long long*)(XN + (size_t)m * D) + ln;
#pragma unroll
        for (int j = 0; j < 4; ++j) { v[j] = v[j] * rs * gq[j];
            o8[64 * j] = (unsigned long long)pk2(v[j].x, v[j].y) | ((unsigned long long)pk2(v[j].z, v[j].w) << 32);
#pragma unroll
            for (int i = 0; i < 4; ++i) { const int k = 4 * ln + 256 * j + i; const f32x4 w0 = *(const LAS f32x4*)(Wf + k * 8), w1 = *(const LAS f32x4*)(Wf + k * 8 + 4); const float hv = v[j][i];
                fa[0] += hv * w0.x; fa[1] += hv * w0.y; fa[2] += hv * w0.z; fa[3] += hv * w0.w; fa[4] += hv * w1.x; fa[5] += hv * w1.y; fa[6] += hv * w1.z; fa[7] += hv * w1.w; } }
#pragma unroll
        for (int h = 0; h < 8; ++h) fa[h] = wave_sum(fa[h]);
        if (ln < 8) { float f = fa[0];
#pragma unroll
            for (int h = 1; h < 8; ++h) f = (ln == h) ? fa[h] : f;
            f += bfg;
            const float lf = fminf(f, 0.f) - log1pf(expf(-fabsf(f)));
            const int b = m / SEQ, s_ = m % SEQ; LOGF[(size_t)(b * 8 + ln) * SEQ + s_] = lf; }
        s = 0.f;
#pragma unroll
        for (int j = 0; j < 4; ++j) { v[j] = nv[j]; s += (v[j].x * v[j].x + v[j].y * v[j].y) + (v[j].z * v[j].z + v[j].w * v[j].w); }
      } }
    __syncthreads();
}

__global__ void __launch_bounds__(NTHR, 2) fwd_kernel(Args args) {
    extern __shared__ __attribute__((aligned(16))) unsigned char lds[];
    Frame F;
    F.lds = (LAS unsigned char*)lds; F.tid = threadIdx.x; F.wave = __builtin_amdgcn_readfirstlane(F.tid >> 6); F.G = gridDim.x; F.bid = blockIdx.x;
    F.x = args.in[0]; F.g_attn = args.in[1]; F.w_in = args.in[2]; F.b_forget = args.in[3]; F.g_fox = args.in[4]; F.g_sb = args.in[5]; F.w_out = args.in[6]; F.g_ffn = args.in[7];
    F.w_router = args.in[8]; F.b_router = args.in[9]; F.w_gu = args.in[10]; F.b_gu = args.in[11]; F.w_d = args.in[12]; F.b_d = args.in[13]; F.g_final = args.in[14];
    F.out = args.out; F.ws = args.ws;
    volatile LAS unsigned* MISC = (volatile LAS unsigned*)(F.lds + MISC_OFF);
    for (int u = F.tid; u < (LDS_BYTES - 131072) / 4; u += NTHR) ((LAS unsigned*)(F.lds + 131072))[u] = 0u;
    __syncthreads();
    unsigned* ctl = (unsigned*)(F.ws + WS_CTL);
    XcdBarrier bar = xcd_barrier_post(ctl + CW_BAR, MISC + 8);
    const int lo = args.ph_lo, hi = args.ph_hi;
#define IN(k) (lo <= (k) && (k) < hi)
#define SEAM(k) do { if (IN(k) && IN((k) + 1)) xcd_barrier(bar); } while (0)
    LAS float* As = (LAS float*)F.lds;

    if (IN(0)) { p0_prologue(F); }
    SEAM(0);
    if (IN(1)) {
        for (int j = F.bid; j < 16; j += F.G) {
            const float* lf = (const float*)(F.ws + WS_LOGF) + (size_t)j * SEQ; float* cl = (float*)(F.ws + WS_CL) + (size_t)j * SEQ;
            LAS float* part = (LAS float*)F.lds;
            float v[16]; float s = 0.f;
#pragma unroll
            for (int i = 0; i < 16; ++i) { s += lf[F.tid * 16 + i]; v[i] = s; }
            __syncthreads(); part[F.tid] = s; __syncthreads();
            if (F.tid == 0) { float run = 0.f; for (int i = 0; i < NTHR; ++i) { const float tmp = part[i]; part[i] = run; run += tmp; } }
            __syncthreads();
            const float base = part[F.tid];
#pragma unroll
            for (int i = 0; i < 16; ++i) cl[F.tid * 16 + i] = (base + v[i]) * LOG2E;
            __syncthreads();
        }
        __syncthreads();
        { pg8::Gemm g{(const bf16*)(F.ws + WS_XN), (const bf16*)(F.ws + WS_WIN), M, 3 * D, D}; pg8::StaticOrder S; S.init(M, 3 * D, F.G, F.bid);
          pg8::EpiQKV E{(bf16*)(F.ws + WS_Q), (size_t)(WS_K - WS_Q) / 2, C2, ctl + CW_KN};
          pg8::gemm_phase<pg8::EpiQKV, pg8::StaticOrder, true, true>(F.lds, g, S, E); }
    }
    SEAM(1);
    if (IN(2)) {
        const int v0 = (F.G % 8 == 0) ? (F.bid % 8) * (F.G / 8) + F.bid / 8 : F.bid;
        if (F.tid < 16) { ((LAS unsigned*)(F.lds + att::G_DONE))[F.tid] = 0u; ((LAS unsigned*)(F.lds + att::G_ARR))[F.tid] = 0u;
                          ((LAS unsigned*)(F.lds + att::G_BYTES + att::G_DONE))[F.tid] = 0u; ((LAS unsigned*)(F.lds + att::G_BYTES + att::G_ARR))[F.tid] = 0u; }
        __syncthreads();
        const bf16* QO = (const bf16*)(F.ws + WS_Q); bf16* OB = (bf16*)(F.ws + WS_O); const bf16* KB = (const bf16*)(F.ws + WS_K); const bf16* VB = (const bf16*)(F.ws + WS_V); float* SSQ = (float*)(F.ws + WS_SSQ);
        if (F.wave < 4) { __builtin_amdgcn_s_setprio(3);
            unsigned epoch = 0u;
            for (int v = v0; v < 256; v += F.G) {
                const int bh = v >> 4, s_ = v & 15, b = bh >> 3, h = bh & 7;
                const float KN = sqrtf(__uint_as_float(ctl[CW_KN + (b * 16 + h) * 2]) + __uint_as_float(ctl[CW_KN + (b * 16 + h) * 2 + 1])) * 1.02f;
                const float* CLrow = (const float*)(F.ws + WS_CL) + (size_t)(b * 8 + h) * SEQ;
#pragma unroll 1
                for (int u = 0; u < 4; ++u) { const int qb = (u == 0) ? 63 - s_ : (u == 1) ? 47 - s_ : (u == 2) ? 16 + s_ : s_;
                    att::attn_unit4<true, ATT_PRUNE != 0>(b, h, qb, QO, OB, KB, VB, SSQ, CLrow, KN, (char*)lds, epoch);
                    if (u < 2) att::attn_unit4<false, ATT_PRUNE != 0>(b, 8 + h, qb, QO, OB, KB, VB, SSQ, nullptr, 0.f, (char*)lds, epoch); }
            }
            __builtin_amdgcn_s_setprio(0);
        } else {
            LAS unsigned* scr = (LAS unsigned*)(F.lds + att::G_BYTES + (F.wave - 4) * 4608);
            bf16* Wgu_t = (bf16*)(F.ws + WS_WGU); bf16* Wd_t = (bf16*)(F.ws + WS_WD);
            constexpr int I_GU = 8 * 64, I_D = 8 * 32;
            for (int it = v0 * 4 + (F.wave - 4); it < NE * (I_GU + I_D); it += 4 * F.G) {
                int r = it;
                if (r < NE * I_GU) { const int e = r / I_GU; r -= e * I_GU; transpose_item_fp8(F.w_gu + (size_t)e * D * 2 * DFF, 2 * DFF, D, (unsigned char*)Wgu_t + (size_t)e * 2 * DFF * D, r, 64, scr, hw_lane(), W8_SCALE); }
                else { r -= NE * I_GU; const int e = r / I_D; r -= e * I_D; transpose_item_fp8(F.w_d + (size_t)e * DFF * D, D, DFF, (unsigned char*)Wd_t + (size_t)e * D * DFF, r, 32, scr, hw_lane(), W8_SCALE); }
            }
            unsigned epoch = 0u;
            for (int v = v0; v < 256; v += F.G) {
                const int bh = v >> 4, s_ = v & 15, b = bh >> 3, h = bh & 7;
#pragma unroll 1
                for (int u = 2; u < 4; ++u) { const int qb = (u == 2) ? 16 + s_ : s_;
                    att::attn_unit4<false, ATT_PRUNE != 0>(b, 8 + h, qb, QO, OB, KB, VB, SSQ, nullptr, 0.f, (char*)lds + att::G_BYTES, epoch); }
            }
        }
        __syncthreads();
    }
    SEAM(2);
    if (IN(4)) {
        pg8::Gemm g{(const bf16*)(F.ws + WS_O), (const bf16*)(F.ws + WS_WOUT), M, D, D}; pg8::StaticOrder S; S.init(M, D, F.G, F.bid);
        pg8::EpiResMid E{F.x, (unsigned short*)(F.ws + WS_X1), D, (const float*)(F.ws + WS_SSQ), (LAS float*)(F.lds + 131072)};
        pg8::gemm_phase<pg8::EpiResMid, pg8::StaticOrder, true, true>(F.lds, g, S, E);
    }
    SEAM(4);
    if (IN(5)) {
        unsigned char* H8 = (unsigned char*)(F.ws + WS_XN); int* TOPE = (int*)(F.ws + WS_TOPE); float* GATE = (float*)(F.ws + WS_GATE); int* CNT = (int*)(F.ws + WS_CNT); const unsigned short* X1 = (const unsigned short*)(F.ws + WS_X1);
        constexpr int WP = 1028;
        LAS float* Wt = (LAS float*)F.lds;
        LAS float* Lg = (LAS float*)(F.lds + 32 * WP * 4);
        LAS float* RS = Lg + 64 * 32;
        LAS int* hist = (LAS int*)(RS + 64);
        __syncthreads();
        { f32x4 wv[16];
#pragma unroll
          for (int it = 0; it < 16; ++it) wv[it] = ((const GAS f32x4*)F.w_router)[F.tid + it * NTHR];
#pragma unroll
          for (int it = 0; it < 16; ++it) { const int i = F.tid + it * NTHR; const int k = i >> 3, e0 = (i & 7) * 4; const f32x4 w = wv[it] * F.g_ffn[k];
            Wt[(e0 + 0) * WP + k] = w.x; Wt[(e0 + 1) * WP + k] = w.y; Wt[(e0 + 2) * WP + k] = w.z; Wt[(e0 + 3) * WP + k] = w.w; } }
        const int ln = hw_lane(), mt = F.wave >> 1, kh = F.wave & 1, r16 = ln & 15, kq = ln >> 4;
        const float brt0 = F.b_router[r16], brt1 = F.b_router[16 + r16];
        LAS float* Pp = Lg;
        for (int vb = F.bid; vb < NVB; vb += F.G) {
            __syncthreads(); if (F.tid < NE) hist[F.tid] = 0;
            { const unsigned short* xrow = X1 + (size_t)(vb * VBT + mt * 16 + r16) * D + 512 * kh + 4 * kq; const LAS float* wrow = Wt + r16 * WP + 512 * kh + 4 * kq;
              f32x4 acc0 = {0.f, 0.f, 0.f, 0.f}, acc1 = {0.f, 0.f, 0.f, 0.f}; float ssq = 0.f;
              v2u_b nx[8];
#pragma unroll
              for (int u = 0; u < 8; ++u) nx[u] = *(const GAS v2u_b*)(xrow + 16 * u);
#pragma unroll 1
              for (int i0 = 0; i0 < 32; i0 += 8) { f32x4 av[8];
#pragma unroll
                  for (int u = 0; u < 8; ++u) av[u] = bf4(nx[u]);
                  if (i0 + 8 < 32) {
#pragma unroll
                      for (int u = 0; u < 8; ++u) nx[u] = *(const GAS v2u_b*)(xrow + 16 * (i0 + 8 + u)); }
#pragma unroll
                  for (int u = 0; u < 8; ++u) { const f32x4 b0 = *(const LAS f32x4*)(wrow + 16 * (i0 + u)), b1 = *(const LAS f32x4*)(wrow + 16 * WP + 16 * (i0 + u)); const f32x4 a = av[u];
                      ssq += (a.x * a.x + a.y * a.y) + (a.z * a.z + a.w * a.w);
                      acc0 = __builtin_amdgcn_mfma_f32_16x16x4f32(a.x, b0.x, acc0, 0, 0, 0); acc1 = __builtin_amdgcn_mfma_f32_16x16x4f32(a.x, b1.x, acc1, 0, 0, 0);
                      acc0 = __builtin_amdgcn_mfma_f32_16x16x4f32(a.y, b0.y, acc0, 0, 0, 0); acc1 = __builtin_amdgcn_mfma_f32_16x16x4f32(a.y, b1.y, acc1, 0, 0, 0);
                      acc0 = __builtin_amdgcn_mfma_f32_16x16x4f32(a.z, b0.z, acc0, 0, 0, 0); acc1 = __builtin_amdgcn_mfma_f32_16x16x4f32(a.z, b1.z, acc1, 0, 0, 0);
                      acc0 = __builtin_amdgcn_mfma_f32_16x16x4f32(a.w, b0.w, acc0, 0, 0, 0); acc1 = __builtin_amdgcn_mfma_f32_16x16x4f32(a.w, b1.w, acc1, 0, 0, 0); } }
              ssq += __shfl_xor(ssq, 16); ssq += __shfl_xor(ssq, 32);
              if (kh == 1) { *(LAS f32x4*)(Pp + ((mt * 2 + 0) * 64 + ln) * 4) = acc0; *(LAS f32x4*)(Pp + ((mt * 2 + 1) * 64 + ln) * 4) = acc1; if (kq == 0) RS[mt * 16 + r16] = ssq; }
              __syncthreads();
              if (kh == 0) { const f32x4 q0 = *(const LAS f32x4*)(Pp + ((mt * 2 + 0) * 64 + ln) * 4), q1 = *(const LAS f32x4*)(Pp + ((mt * 2 + 1) * 64 + ln) * 4);
                  acc0 = acc0 + q0; acc1 = acc1 + q1; ssq += RS[mt * 16 + r16];
                  const float rsr = 1.0f / sqrtf(ssq * (1.f / D) + EPS);
                  if (kq == 0) RS[mt * 16 + r16] = rsr;
#pragma unroll
                  for (int j = 0; j < 4; ++j) { const int row = 4 * kq + j; const float rsj = __shfl(rsr, row);
                      Lg[(mt * 16 + row) * 32 + r16] = acc0[j] * rsj + brt0; Lg[(mt * 16 + row) * 32 + 16 + r16] = acc1[j] * rsj + brt1; } } }
            __syncthreads();
            for (int rr = 0; rr < VBT / NWAVES; ++rr) {
                const int row = F.wave * (VBT / NWAVES) + rr, m = vb * VBT + row;
                const GAS v2u_b* xr = (const GAS v2u_b*)(X1 + (size_t)m * D) + ln;
                f32x4 v[4];
#pragma unroll
                for (int j = 0; j < 4; ++j) v[j] = bf4(xr[64 * j]);
                const float vv = Lg[row * 32 + (ln & 31)]; const int myi = ln & 31; int rank = 0;
#pragma unroll
                for (int e = 0; e < NE; ++e) { const float se = __builtin_bit_cast(float, __builtin_amdgcn_readlane(__builtin_bit_cast(int, vv), e)); rank += (se > vv || (se == vv && e < myi)) ? 1 : 0; }
                float sv[TOPK]; int si[TOPK];
#pragma unroll
                for (int r = 0; r < TOPK; ++r) { const unsigned long long mk = __ballot(rank == r && ln < 32); const int li = __builtin_amdgcn_readfirstlane((int)__builtin_ctzll(mk));
                    si[r] = li; sv[r] = __builtin_bit_cast(float, __builtin_amdgcn_readlane(__builtin_bit_cast(int, vv), li)); }
                if (ln == 0) { const float x1_ = expf(sv[1] - sv[0]), x2_ = expf(sv[2] - sv[0]), x3_ = expf(sv[3] - sv[0]); const float inv = 1.f / (1.f + x1_ + x2_ + x3_);
                    *(GAS f32x4*)(GATE + (size_t)m * 4) = (f32x4){inv, x1_ * inv, x2_ * inv, x3_ * inv};
                    TOPE[(size_t)m * 4 + 0] = si[0]; TOPE[(size_t)m * 4 + 1] = si[1]; TOPE[(size_t)m * 4 + 2] = si[2]; TOPE[(size_t)m * 4 + 3] = si[3];
                    atomicAdd((int*)&hist[si[0]], 1); atomicAdd((int*)&hist[si[1]], 1); atomicAdd((int*)&hist[si[2]], 1); atomicAdd((int*)&hist[si[3]], 1); }
                const float rs = RS[row] * X8_SCALE;
                GAS unsigned* o4 = (GAS unsigned*)(H8 + (size_t)m * D) + ln;
#pragma unroll
                for (int j = 0; j < 4; ++j) { const f32x4 g = *((const GAS f32x4*)F.g_ffn + ln + 64 * j); const f32x4 h = v[j] * rs * g; o4[64 * j] = pg8::cvt4_fp8(h.x, h.y, h.z, h.w); }
            }
            __syncthreads();
            if (F.tid < NE) CNT[vb * NE + F.tid] = hist[F.tid];
        }
        __syncthreads();
    }
    SEAM(5);
    if (IN(6)) {
        const int* TOPE = (const int*)(F.ws + WS_TOPE); const float* GATE = (const float*)(F.ws + WS_GATE); const int* CNT = (const int*)(F.ws + WS_CNT);
        int* ROWTOK = (int*)(F.ws + WS_ROWTOK); int* ROWDST = (int*)(F.ws + WS_ROWDST); float* GSLOT = (float*)(F.ws + WS_GSLOT2); int* TILE = (int*)(F.ws + WS_TILE);
        LAS int* es = (LAS int*)F.lds; LAS int* tot = es + 256; LAS int* bef = tot + 32; LAS int* ps = bef + 32; LAS int* part = ps + 32;
        for (int vb = F.bid; vb < NVB; vb += F.G) {
            __syncthreads();
            if (F.tid < 256) es[F.tid] = TOPE[(size_t)vb * VBT * 4 + F.tid];
            { const int e = F.tid & 31, qg = F.tid >> 5; int cv[16];
#pragma unroll
              for (int i = 0; i < 16; ++i) cv[i] = CNT[(qg * 16 + i) * NE + e];
              int t_ = 0, b_ = 0;
#pragma unroll
              for (int i = 0; i < 16; ++i) { t_ += cv[i]; b_ += (qg * 16 + i < vb) ? cv[i] : 0; }
              part[qg * 32 + e] = t_; part[512 + qg * 32 + e] = b_; }
            __syncthreads();
            if (F.tid < NE) { int t_ = 0, b_ = 0;
#pragma unroll
                for (int qg = 0; qg < 16; ++qg) { t_ += part[qg * 32 + F.tid]; b_ += part[512 + qg * 32 + F.tid]; }
                tot[F.tid] = t_; bef[F.tid] = b_; }
            __syncthreads();
            if (F.tid < NE) { int nt = 0;
                for (int e = 0; e < F.tid; ++e) nt += (tot[e] + 255) / 256;
                ps[F.tid] = nt * 256;
                if (vb == NE) { const int k = (tot[F.tid] + 255) / 256; for (int i = 0; i < k; ++i) TILE[16 + nt + i] = F.tid; if (F.tid == NE - 1) TILE[0] = nt + k; } }
            __syncthreads();
            if (F.tid < 256) { const int e = es[F.tid]; int rank = 0;
#pragma unroll 8
                for (int j4 = 0; j4 < 64; ++j4) { const v4u q = *(const LAS v4u*)(es + 4 * j4); const int j = 4 * j4;
                    rank += ((int)q.x == e && j < F.tid) + ((int)q.y == e && j + 1 < F.tid) + ((int)q.z == e && j + 2 < F.tid) + ((int)q.w == e && j + 3 < F.tid); }
                const int slot = ps[e] + bef[e] + rank; const int a = vb * VBT * 4 + F.tid; ROWTOK[slot] = a >> 2; ROWDST[slot] = a; GSLOT[slot] = GATE[a];  }
            if (vb < NE) {
                const int n0 = ps[vb] + tot[vb], n1 = ps[vb] + (tot[vb] + 255) / 256 * 256;
                for (int r = n0 + F.tid; r < n1; r += NTHR) { ROWTOK[r] = 0; ROWDST[r] = -1; GSLOT[r] = 0.f; } }
        }
    }
    SEAM(6);
    if (IN(7)) {
        pg8::Gemm g{(const bf16*)(F.ws + WS_XN), (const bf16*)(F.ws + WS_WGU), MAXROWS, 2 * DFF, D / 2}; pg8::GroupedOrder S; S.init((const int*)(F.ws + WS_TILE), 8, F.G, F.bid);
        pg8::EpiSwiglu E{(unsigned char*)(F.ws + WS_ACT), F.b_gu, 1.f / (X8_SCALE * W8_SCALE), A8_SCALE};
        pg8::gemm_phase<pg8::EpiSwiglu, pg8::GroupedOrder, true, true, true, true>(F.lds, g, S, E, (const int*)(F.ws + WS_ROWTOK));
    }
    SEAM(7);
    if (IN(8)) {
        pg8::Gemm g{(const bf16*)(F.ws + WS_ACT), (const bf16*)(F.ws + WS_WD), MAXROWS, D, DFF / 2}; pg8::GroupedOrder S; S.init((const int*)(F.ws + WS_TILE), 4, F.G, F.bid);
        pg8::EpiDownG E{(unsigned char*)(F.ws + WS_XS), F.b_d, (const float*)(F.ws + WS_GSLOT2), (const int*)(F.ws + WS_ROWDST), 1.f / (A8_SCALE * W8_SCALE), Y8_SCALE};
        pg8::gemm_phase<pg8::EpiDownG, pg8::GroupedOrder, true, true, false, true>(F.lds, g, S, E);
    }
    SEAM(8);
    if (IN(9)) {
        const bf16* Y = (const bf16*)(F.ws + WS_XS);
        const int gw = F.bid * NWAVES + F.wave, NGW = F.G * NWAVES;
        for (int m = gw; m < M; m += NGW) {
            GAS f32x4* xr = (GAS f32x4*)(F.out + (size_t)m * D) + hw_lane(); const GAS v2u_b* x1r = (const GAS v2u_b*)((const unsigned short*)(F.ws + WS_X1) + (size_t)m * D) + hw_lane();
            f32x4 v[4];
#pragma unroll
            for (int j = 0; j < 4; ++j) v[j] = bf4(x1r[64 * j]);
#pragma unroll
            for (int k = 0; k < TOPK; ++k) { const GAS unsigned* yr = (const GAS unsigned*)((const unsigned char*)Y + ((size_t)m * 4 + k) * D) + hw_lane();
#pragma unroll
                for (int j = 0; j < 4; ++j) { const unsigned w = yr[64 * j]; typedef float f2_ __attribute__((ext_vector_type(2))); const f2_ lo = __builtin_amdgcn_cvt_pk_f32_fp8((int)w, false), hi = __builtin_amdgcn_cvt_pk_f32_fp8((int)w, true);
                    v[j].x += lo.x * (1.f / Y8_SCALE); v[j].y += lo.y * (1.f / Y8_SCALE); v[j].z += hi.x * (1.f / Y8_SCALE); v[j].w += hi.y * (1.f / Y8_SCALE); } }
            float s = 0.f;
#pragma unroll
            for (int j = 0; j < 4; ++j) s += (v[j].x * v[j].x + v[j].y * v[j].y) + (v[j].z * v[j].z + v[j].w * v[j].w);
            const float rs = 1.0f / sqrtf(wave_sum(s) * (1.f / D) + EPS);
#pragma unroll
            for (int j = 0; j < 4; ++j) { const f32x4 g = *((const GAS f32x4*)F.g_final + hw_lane() + 64 * j); xr[64 * j] = v[j] * rs * g; }
        }
    }
#undef IN
#undef SEAM
}

extern "C" void kernel_launch(void* const* d_in, const int* in_sizes, int n_in, void* d_out, int out_size, void* d_ws, size_t ws_size, hipStream_t stream) {
    static int grid = 0;
    if (grid == 0) {
        if (n_in != 15 || out_size != M * D || ws_size < WS_END) { fprintf(stderr, "kernel_launch: unexpected problem (n_in %d out %d ws %zu)\n", n_in, out_size, ws_size); grid = -1; return; }
        int dev = 0, cus = 0, per_cu = 0;
        if (hipGetDevice(&dev) != hipSuccess || hipDeviceGetAttribute(&cus, hipDeviceAttributeMultiprocessorCount, dev) != hipSuccess) { grid = -1; return; }
        if (hipFuncSetAttribute((const void*)fwd_kernel, hipFuncAttributeMaxDynamicSharedMemorySize, LDS_BYTES) != hipSuccess) { fprintf(stderr, "kernel_launch: hipFuncSetAttribute failed\n"); grid = -1; return; }
        if (hipOccupancyMaxActiveBlocksPerMultiprocessor(&per_cu, (const void*)fwd_kernel, NTHR, LDS_BYTES) != hipSuccess || per_cu < 1) { fprintf(stderr, "kernel_launch: occupancy query says %d blocks/CU\n", per_cu); (void)hipGetLastError(); grid = -1; return; }
        grid = cus;
    }
    if (grid < 0) return;
    if (hipMemsetAsync((char*)d_ws + WS_CTL, 0, CTL_ZERO_BYTES, stream) != hipSuccess) return;
    Args a{};
    for (int i = 0; i < 15; ++i) a.in[i] = (const float*)d_in[i];
    a.out = (float*)d_out; a.ws = (unsigned char*)d_ws; a.ph_lo = 0; a.ph_hi = 10;
    hipLaunchKernelGGL(fwd_kernel, dim3(grid), dim3(NTHR), LDS_BYTES, stream, a);
}
```

```cpp
#include <hip/hip_runtime.h>
#include <cstdio>
#include <cstdint>

#define GAS __attribute__((address_space(1)))
#define LAS __attribute__((address_space(3)))
typedef unsigned short bf16;
typedef float f32x4 __attribute__((ext_vector_type(4)));
typedef unsigned v4u __attribute__((ext_vector_type(4)));
typedef unsigned v2u __attribute__((ext_vector_type(2)));
typedef GAS unsigned gu32;
#define RLX_AGENT __ATOMIC_RELAXED, __HIP_MEMORY_SCOPE_AGENT
#define LDS_WAIT() asm volatile("s_waitcnt lgkmcnt(0)" ::: "memory")
#define VM_WAIT() asm volatile("s_waitcnt vmcnt(0)" ::: "memory")

constexpr int BATCH = 2, SEQ = 8192, D = 1024, M = BATCH * SEQ, NH = 16  , HD = 64;
constexpr int INC = 3080, NE = 32, TOPK = 4, DFF = 1024;
constexpr float EPS = 1e-5f, LOG2E = 1.4426950408889634f, C2 = 0.125f * 1.4426950408889634f;
constexpr int MAXTILES = 288, MAXROWS = MAXTILES * 256;
constexpr int NWAVES = 8, NTHR = 512;
constexpr float W8_SCALE = 64.f, X8_SCALE = 16.f, A8_SCALE = 8.f, Y8_SCALE = 32.f;
constexpr int NVB = 256, VBT = M / NVB;

constexpr size_t MiB = 1u << 20;
constexpr size_t WS_CTL = 0, CTL_ZERO_BYTES = 64 * 1024;
constexpr size_t WS_WIN = 2 * MiB, WS_WOUT = 8 * MiB, WS_WGU = 16 * MiB, WS_WD = 144 * MiB;
constexpr size_t WS_XN = 208 * MiB;
constexpr size_t WS_SSQ = 240 * MiB;
constexpr size_t WS_LOGF = 241 * MiB, WS_CL = WS_LOGF + 512 * 1024;
constexpr size_t WS_TOPE = 242 * MiB, WS_GATE = WS_TOPE + 256 * 1024, WS_SLOT = WS_GATE + 256 * 1024, WS_GSLOT = WS_SLOT + 256 * 1024;
constexpr size_t WS_CNT = 243 * MiB + 256 * 1024, WS_TILE = 243 * MiB + 512 * 1024;
constexpr size_t WS_ROWTOK = 244 * MiB, WS_ROWDST = WS_ROWTOK + 512 * 1024, WS_GSLOT2 = WS_ROWDST + 512 * 1024;
constexpr size_t WS_Q = 256 * MiB, WS_K = 288 * MiB, WS_V = 320 * MiB;
constexpr size_t WS_O = 352 * MiB;
constexpr size_t WS_XS = 256 * MiB;
constexpr size_t WS_ACT = 400 * MiB;
constexpr size_t WS_XS8 = 480 * MiB;
constexpr size_t WS_RS0 = 246 * MiB;
constexpr size_t WS_X1 = 560 * MiB;
constexpr size_t WS_END = 624 * MiB;
constexpr int CW_TC = 0, CW_MAPBAD = 3072, CW_BAR = 4096, CW_KN = 8192;
#ifndef ATT_PRUNE
#define ATT_PRUNE 1
#endif

constexpr int LDS_BYTES = 147456;
constexpr int MISC_OFF = LDS_BYTES - 128;

__device__ __forceinline__ unsigned f2bf(float f) { unsigned u = __builtin_bit_cast(unsigned, f); return (u + 0x7fffu + ((u >> 16) & 1u)) >> 16; }
__device__ __forceinline__ unsigned pk2(float lo, float hi) { return f2bf(lo) | (f2bf(hi) << 16); }
typedef unsigned v2u_b __attribute__((ext_vector_type(2)));
__device__ __forceinline__ f32x4 bf4(v2u_b w) { return (f32x4){__uint_as_float(w.x << 16), __uint_as_float(w.x & 0xffff0000u), __uint_as_float(w.y << 16), __uint_as_float(w.y & 0xffff0000u)}; }
__device__ __forceinline__ float bflo(unsigned w) { return __builtin_bit_cast(float, w << 16); }
__device__ __forceinline__ float bfhi(unsigned w) { return __builtin_bit_cast(float, w & 0xffff0000u); }
__device__ __forceinline__ float wave_sum(float v) {
#pragma unroll
    for (int o = 1; o < 64; o <<= 1) v += __shfl_xor(v, o);
    return v;
}

namespace pg8 {
#define PG8_LAS __attribute__((address_space(3)))
typedef unsigned short bf16_t;
typedef short bf16x8 __attribute__((ext_vector_type(8)));
typedef float f32x4 __attribute__((ext_vector_type(4)));
typedef unsigned u32x4 __attribute__((ext_vector_type(4)));
typedef unsigned u32x2 __attribute__((ext_vector_type(2)));
typedef int i32x4_t __attribute__((ext_vector_type(4)));
constexpr int BM = 256, BK = 64, HALF = 128, HTB = HALF * BK * 2  , STAGE_BYTES = 8 * HTB, NXCD = 8, WGM = 8;

__host__ __device__ __forceinline__ int lds_byte(int r, int c) { const int st = (r >> 4) * 2 + (c >> 5), rr = r & 15, cc = c & 31, ob = rr * 64 + cc * 2; return st * 1024 + (ob ^ (((ob >> 9) & 1) << 5)); }
__host__ __device__ __forceinline__ void stage_rc(int b, int& R, int& C) { const int st = b / 1024, sb = b % 1024, swz = sb ^ (((sb >> 9) & 1) << 5); R = (st >> 1) * 16 + swz / 64; C = (st & 1) * 32 + (swz % 64) / 2; }
__host__ __device__ __forceinline__ int perm32(int rho) { const int n = rho >> 4, i = rho & 15; return 8 * (i >> 2) + 4 * n + (i & 3); }

struct Unit { int pm, pn; };
struct Gemm { const bf16_t* A; const bf16_t* Bt; int M, N, K; };

struct StaticOrder {
    int nM, nN, nwg, G, c;
    __host__ __device__ void init(int M, int N, int G_, int c_) { nM = M / BM; nN = N / BM; nwg = nM * nN; G = G_; c = c_; }
    __host__ __device__ bool next(int i, Unit& u) const {
        const long L = (long)i * G + c; if (L >= nwg) return false;
        int wgid = (int)L; { const int q = nwg / NXCD, r = nwg % NXCD, xcd = wgid % NXCD, off = wgid / NXCD; wgid = (xcd < r ? xcd * (q + 1) : r * (q + 1) + (xcd - r) * q) + off; }
        const int nig = WGM * nN, gid = wgid / nig, fm = gid * WGM, gsz = (nM - fm) < WGM ? (nM - fm) : WGM;
        u.pm = fm + ((wgid % nig) % gsz); u.pn = (wgid % nig) / gsz; return true;
    }
    static constexpr int MODE = 0;
    __device__ __forceinline__ void a_ready(const Unit&) const {}
    __device__ __forceinline__ void done(const Unit&) const {}
    __device__ __forceinline__ unsigned flag_load(const Unit&) const { return 0u; }
    __device__ __forceinline__ void a_ready_pref(const Unit&, unsigned) const {}
    __device__ __forceinline__ void publish(int) const {}
};
__device__ __forceinline__ unsigned cvt_pk_bf16(float lo, float hi) { unsigned r; asm volatile("v_cvt_pk_bf16_f32 %0, %1, %2" : "=v"(r) : "v"(lo), "v"(hi)); return r; }
typedef float f32x2 __attribute__((ext_vector_type(2)));
__device__ __forceinline__ f32x2 gelu_pk(f32x2 v) {
    const f32x2 av = __builtin_elementwise_abs(v), d = av * 0.2316418882f + 1.0f;
    f32x2 t; t.x = __builtin_amdgcn_rcpf(d.x); t.y = __builtin_amdgcn_rcpf(d.y);
    f32x2 q = t * 0.5307027145f + (-0.7265760135f); q = q * t + 0.7107068705f; q = q * t + (-0.142248368f); q = q * t + 0.127414796f; q = q * t;
    const f32x2 s = (v * v) * (-0.72134752044f);
    f32x2 e; e.x = __builtin_amdgcn_exp2f(s.x); e.y = __builtin_amdgcn_exp2f(s.y);
    const f32x2 m = v * (q * e), r = v - m;
    f32x2 o; o.x = v.x < 0.f ? m.x : r.x; o.y = v.y < 0.f ? m.y : r.y; return o;
}

template <int ACT  > struct EpiBf16 {
    static constexpr bool PERM = true, AFTER_DRAIN = false, MIDK = false; static_assert(ACT == 0 || ACT == 1, "EpiBf16: ACT is 0 (none) or 1 (gelu_pk)");
    bf16_t* O; int ldc; const float* bias; int split_cols; size_t split_stride; float scale0;
    __device__ __forceinline__ void operator()(const f32x4 (&acc)[2][2][4][2], const Unit& u, int wr, int wc, int fr, int fq) const {
        const int row0 = u.pm * BM + wr * 64 + fr; int colt = u.pn * BM; bf16_t* base = O;
        float sc = 1.f; if (split_cols) { const int t = colt / split_cols; base += (size_t)t * split_stride; colt -= t * split_cols; if (t == 0) sc = scale0; }
        const int col0 = colt + wc * 32 + 8 * fq, bcol0 = u.pn * BM + wc * 32 + 8 * fq;
        f32x4 bv[2][2];
#pragma unroll
        for (int bj = 0; bj < 2; ++bj)
#pragma unroll
            for (int n = 0; n < 2; ++n) bv[bj][n] = bias ? *(const f32x4*)(bias + bcol0 + bj * HALF + 4 * n) : (f32x4){0.f, 0.f, 0.f, 0.f};
#pragma unroll
        for (int ai = 0; ai < 2; ++ai)
#pragma unroll
            for (int m = 0; m < 4; ++m) { bf16_t* rowp = base + (size_t)(row0 + ai * HALF + m * 16) * ldc + col0;
#pragma unroll
                for (int bj = 0; bj < 2; ++bj) { f32x4 v0 = acc[ai][bj][m][0] + bv[bj][0], v1 = acc[ai][bj][m][1] + bv[bj][1];
                    if (ACT == 1) { f32x2 a = gelu_pk((f32x2){v0[0], v0[1]}), b = gelu_pk((f32x2){v0[2], v0[3]}), c = gelu_pk((f32x2){v1[0], v1[1]}), d = gelu_pk((f32x2){v1[2], v1[3]});
                        v0 = (f32x4){a.x, a.y, b.x, b.y}; v1 = (f32x4){c.x, c.y, d.x, d.y}; }
                    v0 = v0 * sc; v1 = v1 * sc; u32x4 w; w.x = cvt_pk_bf16(v0[0], v0[1]); w.y = cvt_pk_bf16(v0[2], v0[3]); w.z = cvt_pk_bf16(v1[0], v1[1]); w.w = cvt_pk_bf16(v1[2], v1[3]);
                    *(u32x4*)(rowp + bj * HALF) = w; } }
    }
};

struct EpiResF32 { static constexpr bool PERM = false, AFTER_DRAIN = false, MIDK = false; const float* base; float* out; int ldc;
    __device__ __forceinline__ void operator()(const f32x4 (&acc)[2][2][4][2], const Unit& u, int wr, int wc, int fr, int fq) const {
        const int col0 = u.pn * BM + wc * 32 + 4 * fq;
#pragma unroll
        for (int ai = 0; ai < 2; ++ai)
#pragma unroll
            for (int m = 0; m < 4; ++m) { const size_t off = (size_t)(u.pm * BM + ai * HALF + wr * 64 + m * 16 + fr) * ldc + col0;
#pragma unroll
                for (int bj = 0; bj < 2; ++bj)
#pragma unroll
                    for (int n = 0; n < 2; ++n) { const f32x4 b = *(const f32x4*)(base + off + bj * HALF + n * 16); *(f32x4*)(out + off + bj * HALF + n * 16) = b + acc[ai][bj][m][n]; } }
    } };

struct EpiResMid { static constexpr bool PERM = false, AFTER_DRAIN = false, MIDK = true; const unsigned short* base; unsigned short* out; int ldc; const float* ssq; PG8_LAS float* tab;
    __device__ __forceinline__ void prep(const Unit& u, int par, int tid) const {
        if (tid < 256) { const f32x4* sp = (const f32x4*)(ssq + (size_t)(u.pm * BM + tid) * 16); const f32x4 s0 = sp[0], s1 = sp[1], s2 = sp[2], s3 = sp[3];
            const float sa = (s0[0] + s0[1]) + (s0[2] + s0[3]) + (s1[0] + s1[1]) + (s1[2] + s1[3]), sb = (s2[0] + s2[1]) + (s2[2] + s2[3]) + (s3[0] + s3[1]) + (s3[2] + s3[3]);
            const float rsa = 1.0f / sqrtf(sa * (1.f / 512.f) + 1e-5f), rsb = 1.0f / sqrtf(sb * (1.f / 512.f) + 1e-5f);
            tab[(par * 256 + tid) * 2] = rsa / rsb; tab[(par * 256 + tid) * 2 + 1] = rsb; } }
    __device__ __forceinline__ void midk(f32x4 (&acc)[2][2][4][2], int par, int wr, int fr) const {
#pragma unroll
        for (int ai = 0; ai < 2; ++ai)
#pragma unroll
            for (int m = 0; m < 4; ++m) { const float f = tab[(par * 256 + ai * HALF + wr * 64 + m * 16 + fr) * 2];
#pragma unroll
                for (int bj = 0; bj < 2; ++bj)
#pragma unroll
                    for (int n = 0; n < 2; ++n) acc[ai][bj][m][n] *= f; } }
    __device__ __forceinline__ void epi(const f32x4 (&acc)[2][2][4][2], const Unit& u, int par, int wr, int wc, int fr, int fq) const {
        const int col0 = u.pn * BM + wc * 32 + 4 * fq;
#pragma unroll
        for (int ai = 0; ai < 2; ++ai)
#pragma unroll
            for (int m = 0; m < 4; ++m) { const int r = ai * HALF + wr * 64 + m * 16 + fr; const float f = tab[(par * 256 + r) * 2 + 1]; const size_t off = (size_t)(u.pm * BM + r) * ldc + col0;
#pragma unroll
                for (int bj = 0; bj < 2; ++bj)
#pragma unroll
                    for (int n = 0; n < 2; ++n) { const f32x4 b = bf4(*(const u32x2*)(base + off + bj * HALF + n * 16)); const f32x4 v = b + acc[ai][bj][m][n] * f;
                        u32x2 w; w.x = cvt_pk_bf16(v[0], v[1]); w.y = cvt_pk_bf16(v[2], v[3]); *(u32x2*)(out + off + bj * HALF + n * 16) = w; } } }
    __device__ __forceinline__ void operator()(const f32x4 (&)[2][2][4][2], const Unit&, int, int, int, int) const {}
};
__device__ __forceinline__ float sgpr_f(unsigned bits) { return __builtin_bit_cast(float, __builtin_amdgcn_readfirstlane((int)bits)); }
__device__ __forceinline__ float swiglu1(float g, float u) { const float c7 = sgpr_f(0x40e00000u); g = fminf(g, c7); u = fminf(fmaxf(u, -c7), c7); const float s = __builtin_amdgcn_rcpf(1.f + __builtin_amdgcn_exp2f(g * (-1.702f * 1.4426950408889634f))); return g * s * (u + 1.f); }
__device__ __forceinline__ unsigned cvt4_fp8(float a, float b, float c, float d) {
    const float mx = __builtin_bit_cast(float, __builtin_amdgcn_readfirstlane(0x43e00000)); a = fminf(fmaxf(a, -mx), mx); b = fminf(fmaxf(b, -mx), mx); c = fminf(fmaxf(c, -mx), mx); d = fminf(fmaxf(d, -mx), mx);
    int w = 0; w = __builtin_amdgcn_cvt_pk_fp8_f32(a, b, w, false); w = __builtin_amdgcn_cvt_pk_fp8_f32(c, d, w, true); return (unsigned)w; }
struct EpiSwiglu { static constexpr bool PERM = true, AFTER_DRAIN = false, MIDK = false; unsigned char* ACT; const float* bias; float sc_in, sc_out;
    __device__ __forceinline__ void operator()(const f32x4 (&acc)[2][2][4][2], const Unit& u, int wr, int wc, int fr, int fq) const {
        const int e = u.pn >> 3, pn = u.pn & 7; const int colg = pn * BM + wc * 32 + 8 * fq; const int row0 = u.pm * BM + wr * 64 + fr;
        f32x4 bv[2][2];
#pragma unroll
        for (int bj = 0; bj < 2; ++bj)
#pragma unroll
            for (int n = 0; n < 2; ++n) bv[bj][n] = *(const f32x4*)(bias + (size_t)e * 2048 + colg + bj * HALF + 4 * n);
#pragma unroll
        for (int ai = 0; ai < 2; ++ai)
#pragma unroll
            for (int m = 0; m < 4; ++m) { unsigned char* rowp = ACT + (size_t)(row0 + ai * HALF + m * 16) * 1024 + (colg >> 1);
#pragma unroll
                for (int bj = 0; bj < 2; ++bj) { const f32x4 v0 = acc[ai][bj][m][0] * sc_in + bv[bj][0], v1 = acc[ai][bj][m][1] * sc_in + bv[bj][1];
                    *(unsigned*)(rowp + bj * (HALF / 2)) = cvt4_fp8(swiglu1(v0[0], v0[1]) * sc_out, swiglu1(v0[2], v0[3]) * sc_out, swiglu1(v1[0], v1[1]) * sc_out, swiglu1(v1[2], v1[3]) * sc_out); } }
    } };
struct EpiDownG { static constexpr bool PERM = true, AFTER_DRAIN = false, MIDK = false; unsigned char* Y; const float* bias; const float* gs; const int* rowdst; float sc_in, sc_out;
    __device__ __forceinline__ void operator()(const f32x4 (&acc)[2][2][4][2], const Unit& u, int wr, int wc, int fr, int fq) const {
        const int e = u.pn >> 2, pn = u.pn & 3; const int col = pn * BM + wc * 32 + 8 * fq; const int row0 = u.pm * BM + wr * 64 + fr;
        f32x4 bv[2][2];
#pragma unroll
        for (int bj = 0; bj < 2; ++bj)
#pragma unroll
            for (int n = 0; n < 2; ++n) bv[bj][n] = *(const f32x4*)(bias + (size_t)e * 1024 + col + bj * HALF + 4 * n);
        int dstv[2][4]; float gv[2][4];
#pragma unroll
        for (int ai = 0; ai < 2; ++ai)
#pragma unroll
            for (int m = 0; m < 4; ++m) { const int row = row0 + ai * HALF + m * 16; dstv[ai][m] = rowdst[row]; gv[ai][m] = gs[row]; }
#pragma unroll
        for (int ai = 0; ai < 2; ++ai)
#pragma unroll
            for (int m = 0; m < 4; ++m) { const float g = gv[ai][m] * sc_out; const int dst = dstv[ai][m];
                if (dst >= 0) { unsigned char* rowp = Y + (size_t)dst * 1024 + col;
#pragma unroll
                    for (int bj = 0; bj < 2; ++bj) { const f32x4 v0 = (acc[ai][bj][m][0] * sc_in + bv[bj][0]) * g, v1 = (acc[ai][bj][m][1] * sc_in + bv[bj][1]) * g;
                        typedef unsigned u32x2v __attribute__((ext_vector_type(2))); u32x2v w; w.x = cvt4_fp8(v0[0], v0[1], v0[2], v0[3]); w.y = cvt4_fp8(v1[0], v1[1], v1[2], v1[3]);
                        *(u32x2v*)(rowp + bj * HALF) = w; } } }
    } };
struct EpiQKV { static constexpr bool PERM = true, AFTER_DRAIN = false, MIDK = false; bf16_t* O; size_t split_stride; float scale0; unsigned* kn2; const float* rs0;
    __device__ __forceinline__ void operator()(const f32x4 (&acc)[2][2][4][2], const Unit& u, int wr, int wc, int fr, int fq) const {
        const int row0 = u.pm * BM + wr * 64 + fr; int colt = u.pn * BM; const int t = colt / 1024; bf16_t* base = O + (size_t)t * split_stride; colt -= t * 1024; const float sc = (t == 0) ? scale0 : 1.f;
        const int col0 = colt + wc * 32 + 8 * fq;
        float mx[2] = {0.f, 0.f};
        float rsv[2][4];
#pragma unroll
        for (int ai = 0; ai < 2; ++ai)
#pragma unroll
            for (int m = 0; m < 4; ++m) rsv[ai][m] = rs0[row0 + ai * HALF + m * 16] * sc;
#pragma unroll
        for (int ai = 0; ai < 2; ++ai)
#pragma unroll
            for (int m = 0; m < 4; ++m) { bf16_t* rowp = base + (size_t)(row0 + ai * HALF + m * 16) * 1024 + col0; const float scr_ = rsv[ai][m];
#pragma unroll
                for (int bj = 0; bj < 2; ++bj) { const f32x4 v0 = acc[ai][bj][m][0] * scr_, v1 = acc[ai][bj][m][1] * scr_;
                    u32x4 w; w.x = cvt_pk_bf16(v0[0], v0[1]); w.y = cvt_pk_bf16(v0[2], v0[3]); w.z = cvt_pk_bf16(v1[0], v1[1]); w.w = cvt_pk_bf16(v1[2], v1[3]);
                    *(u32x4*)(rowp + bj * HALF) = w;
                    if (t == 1) { float s = (v0[0] * v0[0] + v0[1] * v0[1]) + (v0[2] * v0[2] + v0[3] * v0[3]) + (v1[0] * v1[0] + v1[1] * v1[1]) + (v1[2] * v1[2] + v1[3] * v1[3]);
                        s += __shfl_xor(s, 16); s += __shfl_xor(s, 32); mx[bj] = fmaxf(mx[bj], s); } } }
        if (t == 1) {
#pragma unroll
            for (int bj = 0; bj < 2; ++bj) { float m = mx[bj]; m = fmaxf(m, __shfl_xor(m, 1)); m = fmaxf(m, __shfl_xor(m, 2)); m = fmaxf(m, __shfl_xor(m, 4)); m = fmaxf(m, __shfl_xor(m, 8));
                if (fr == 0 && fq == 0) atomicMax(kn2 + ((u.pm >> 5) * 16 + (colt + bj * HALF) / 64 + (wc >> 1)) * 2 + (wc & 1), __float_as_uint(m)); } }
    } };
template <int MODE_>
struct GroupedOrderT {
    static constexpr int MODE = MODE_;
    const int* tile_e; int nN, base, nun, per, j; unsigned* tc; unsigned need;
    __device__ void init(const int* TILE, int nN_, int G_, int c_, unsigned* tc_, unsigned need_, int rot_units) {
        const int nt = __builtin_amdgcn_readfirstlane(TILE[0]); tile_e = TILE + 16; nN = nN_; tc = tc_; need = need_;
        if (G_ % NXCD == 0) { const int x = c_ % NXCD, T0 = (x * nt) / NXCD, T1 = ((x + 1) * nt) / NXCD; per = G_ / NXCD; base = T0 * nN_; nun = (T1 - T0) * nN_;
            const int j0 = rot_units > 0 ? ((T1 - T0) * rot_units) % per : 0; j = (c_ / NXCD - j0 + per) % per; }
        else { per = G_; base = 0; nun = nt * nN_; j = c_; }
    }
    __device__ bool next(int i, Unit& u) const {
        const int l = i * per + j; if (l >= nun) return false;
        const int wgid = base + l; const int pm = wgid / nN, pn = wgid % nN; const int e = __builtin_amdgcn_readfirstlane(tile_e[pm]);
        u.pm = pm; u.pn = e * nN + pn; return true;
    }
    __device__ __forceinline__ void done(const Unit&) const {}
    __device__ __forceinline__ unsigned flag_load(const Unit& u) const {
        if constexpr (MODE == 2) return *(const __attribute__((address_space(4))) unsigned*)(tc + u.pm * 8); else return 0u; }
    __device__ __forceinline__ void a_ready_pref(const Unit& u, unsigned fl) const {
        if constexpr (MODE == 2) { const unsigned* p = tc + u.pm * 8; unsigned t0_, t1_, tv_;
            asm volatile("s_cmp_eq_u32 %[fl], %[need]\n\t"
                         "s_cbranch_scc1 .Lrdy%=\n\t"
                         "s_mov_b32 %[t1], 0\n"
                         ".Lspin%=:\n\t"
                         "s_sleep 1\n\t"
                         "v_mov_b32 %[tv], 0\n\t"
                         "global_load_dword %[tv], %[tv], %[p] sc1\n\t"
                         "s_waitcnt vmcnt(0)\n\t"
                         "v_readfirstlane_b32 %[t0], %[tv]\n\t"
                         "s_add_u32 %[t1], %[t1], 1\n\t"
                         "s_cmp_eq_u32 %[t0], %[need]\n\t"
                         "s_cbranch_scc1 .Lrdy%=\n\t"
                         "s_bitcmp0_b32 %[t1], 22\n\t"
                         "s_cbranch_scc1 .Lspin%=\n"
                         ".Lrdy%=:"
                         : [t0] "=&s"(t0_), [t1] "=&s"(t1_), [tv] "=&v"(tv_) : [fl] "s"(fl), [p] "s"(p), [need] "s"(need) : "scc", "memory"); } }
    __device__ __forceinline__ void a_ready_first(const Unit& u) const {
        if constexpr (MODE == 2) {
            unsigned v, sp = 0u;
            for (;;) { v = (unsigned)__builtin_amdgcn_readfirstlane((int)__hip_atomic_load(tc + u.pm * 8, __ATOMIC_RELAXED, __HIP_MEMORY_SCOPE_AGENT)); if (v == need || ++sp > (1u << 22)) break; __builtin_amdgcn_s_sleep(1); }
            asm volatile("" ::: "memory");
        } }
    __device__ __forceinline__ void a_ready(const Unit& u) const { a_ready_first(u); }
    __device__ __forceinline__ void publish(int pm) const {
        if constexpr (MODE == 1) { if ((threadIdx.x & 63) == 0) (void)__hip_atomic_fetch_add(tc + pm * 8, 1u, __ATOMIC_RELAXED, __HIP_MEMORY_SCOPE_AGENT); } }
};
template <class Epi, class Sched, bool ALIGN_EPI = false, bool SP2 = false, bool GATHER = false, bool FP8 = false>
__device__ __forceinline__ void gemm_phase(PG8_LAS unsigned char* lds, const Gemm g, const Sched& S, const Epi& E, const int* rowtok = nullptr) {
    static_assert(!GATHER || SP2, "GATHER is written for the SP2 loop");
    const int tid = threadIdx.x, wid = __builtin_amdgcn_readfirstlane(tid >> 6), lane = tid & 63, wr = wid >> 2, wc = wid & 3, fr = lane & 15, fq = lane >> 4;
    const int K = g.K, nt = K / BK;
    unsigned voffA[2], voffB[2]; unsigned vA[2][2], nvA[2][2];
#pragma unroll
    for (int i = 0; i < 2; ++i) { int R, C; stage_rc(tid * 16 + i * 8192, R, C); const int Rb = Epi::PERM ? ((R & ~31) + perm32(R & 31)) : R;
        voffA[i] = (unsigned)(R * K + C) * 2u; voffB[i] = (unsigned)(Rb * K + C) * 2u; }
    const unsigned kstep = (unsigned)(BK * 2);
    const unsigned hstep = (unsigned)HALF * K * 2;
    const unsigned tstep = 2 * hstep, r64step = 64u * (unsigned)K * 2u;
    const __amdgpu_buffer_rsrc_t rsA = __builtin_amdgcn_make_buffer_rsrc((void*)g.A, 0, 0x7fffffff, 0x00020000), rsB = __builtin_amdgcn_make_buffer_rsrc((void*)g.Bt, 0, 0x7fffffff, 0x00020000);
    const unsigned ldsw = (unsigned)wid * 1024u;
    const int aoff = lds_byte(wr * 64 + fr, fq * 8), boff = lds_byte(wc * 32 + fr, fq * 8);
#define PG8_SA(b, h) (((b) * 2 + (h)) * HTB)
#define PG8_SB(b, h) ((4 + (b) * 2 + (h)) * HTB)
#define PG8_STAGE_R(rs, bufoff, soff, voff) do { _Pragma("unroll") for (int _i = 0; _i < 2; ++_i)     \
        __builtin_amdgcn_raw_ptr_buffer_load_lds(rs, (PG8_LAS unsigned*)(lds + (bufoff) + ldsw + _i * 8192), 16, (int)(voff)[0], (int)((soff) + _i * r64step), 0, 0); } while (0)
#define PG8_STAGE2(bufoff, soff, v0, v1) do { __builtin_amdgcn_raw_ptr_buffer_load_lds(rsA, (PG8_LAS unsigned*)(lds + (bufoff) + ldsw), 16, (int)(v0), (int)(soff), 0, 0); \
        __builtin_amdgcn_raw_ptr_buffer_load_lds(rsA, (PG8_LAS unsigned*)(lds + (bufoff) + ldsw + 8192), 16, (int)(v1), (int)(soff), 0, 0); } while (0)
#define PG8_STAGE_A(bufoff, h, gbase, nx) do { if constexpr (GATHER) { const unsigned s0_ = (nx) ? nvA[h][0] : vA[h][0], s1_ = (nx) ? nvA[h][1] : vA[h][1]; PG8_STAGE2(bufoff, gbase, s0_, s1_); } \
        else { PG8_STAGE_R(rsA, bufoff, (gbase) + ((h) ? hstep : 0u), voffA); } } while (0)
#define PG8_GATHER_OFFS(dst, un) do { _Pragma("unroll") for (int h_ = 0; h_ < 2; ++h_) _Pragma("unroll") for (int i_ = 0; i_ < 2; ++i_) \
        { int R_, C_; stage_rc(tid * 16 + i_ * 8192, R_, C_); dst[h_][i_] = (unsigned)rowtok[(un).pm * BM + h_ * HALF + R_] * (unsigned)(K * 2) + (unsigned)C_ * 2u; } } while (0)
#define PG8_LDA(dst, b, h) do { _Pragma("unroll") for (int m = 0; m < 4; ++m) _Pragma("unroll") for (int k = 0; k < 2; ++k) dst[m][k] = *(const PG8_LAS bf16x8*)(lds + PG8_SA(b, h) + aoff + m * 2048 + k * 1024); } while (0)
#define PG8_LDB(dst, b, h) do { _Pragma("unroll") for (int n = 0; n < 2; ++n) _Pragma("unroll") for (int k = 0; k < 2; ++k) dst[n][k] = *(const PG8_LAS bf16x8*)(lds + PG8_SB(b, h) + boff + n * 2048 + k * 1024); } while (0)
#define PG8_CAT8(x) __builtin_shufflevector(__builtin_bit_cast(i32x4_t, (x)[0]), __builtin_bit_cast(i32x4_t, (x)[1]), 0, 1, 2, 3, 4, 5, 6, 7)
#define PG8_MMA(ai, bj, At, Bt) do { __builtin_amdgcn_s_setprio(1); _Pragma("unroll") for (int m = 0; m < 4; ++m) _Pragma("unroll") for (int n = 0; n < 2; ++n) { \
        if constexpr (FP8) { acc[ai][bj][m][n] = __builtin_amdgcn_mfma_scale_f32_16x16x128_f8f6f4(PG8_CAT8(Bt[n]), PG8_CAT8(At[m]), acc[ai][bj][m][n], 0, 0, 0, 0, 0, 0); } \
        else { _Pragma("unroll") for (int k = 0; k < 2; ++k) acc[ai][bj][m][n] = __builtin_amdgcn_mfma_f32_16x16x32_bf16(Bt[n][k], At[m][k], acc[ai][bj][m][n], 0, 0, 0); } } \
        __builtin_amdgcn_s_setprio(0); } while (0)
#define PG8_WAIT_V(n) asm volatile("s_waitcnt vmcnt(" #n ")" ::: "memory")
#define PG8_WAIT_L(n) asm volatile("s_waitcnt lgkmcnt(" #n ")" ::: "memory")
#define PG8_BAR __builtin_amdgcn_s_barrier()
#define PG8_SCHED __builtin_amdgcn_sched_barrier(0)
    Unit cur, nxt; int ui = 0;
    if (!S.next(0, cur)) return;
    if constexpr (Epi::MIDK) E.prep(cur, 0, tid);
    f32x4 acc[2][2][4][2];
#pragma unroll
    for (int a = 0; a < 2; ++a)
#pragma unroll
        for (int b = 0; b < 2; ++b)
#pragma unroll
            for (int m = 0; m < 4; ++m)
#pragma unroll
                for (int n = 0; n < 2; ++n) { acc[a][b][m][n] = (f32x4){0.f, 0.f, 0.f, 0.f}; if constexpr (FP8) asm volatile("" : "+v"(acc[a][b][m][n])); }
    bf16x8 At[4][2], B0[2][2], B1[2][2];
    unsigned cA = GATHER ? 0u : (unsigned)cur.pm * tstep; unsigned cB = (unsigned)cur.pn * tstep;
    if constexpr (GATHER) { PG8_GATHER_OFFS(vA, cur); }
    S.a_ready(cur);
    if constexpr (SP2) {
        PG8_STAGE_R(rsB, PG8_SB(0, 0), cB, voffB); PG8_STAGE_R(rsB, PG8_SB(0, 1), cB + hstep, voffB); PG8_STAGE_A(PG8_SA(0, 0), 0, cA, false); PG8_STAGE_A(PG8_SA(0, 1), 1, cA, false);
        if (wr == 1) PG8_BAR;
        PG8_WAIT_V(2); PG8_BAR;
        PG8_STAGE_R(rsB, PG8_SB(1, 0), cB + kstep, voffB); PG8_STAGE_A(PG8_SA(1, 0), 0, cA + kstep, false); PG8_STAGE_R(rsB, PG8_SB(1, 1), cB + hstep + kstep, voffB);
        PG8_WAIT_V(6); PG8_BAR;
    } else {
        PG8_STAGE_R(rsB, PG8_SB(0, 0), cB, voffB); PG8_STAGE_R(rsA, PG8_SA(0, 0), cA, voffA); PG8_STAGE_R(rsB, PG8_SB(0, 1), cB + hstep, voffB); PG8_STAGE_R(rsA, PG8_SA(0, 1), cA + hstep, voffA);
        if (wr == 1) PG8_BAR;
        PG8_WAIT_V(4); PG8_BAR;
        PG8_STAGE_R(rsB, PG8_SB(1, 0), cB + kstep, voffB); PG8_STAGE_R(rsA, PG8_SA(1, 0), cA + kstep, voffA); PG8_STAGE_R(rsB, PG8_SB(1, 1), cB + hstep + kstep, voffB);
        PG8_WAIT_V(6); PG8_BAR;
    }
    int prev_pm = -1;
    for (;;) {
        const bool has_next = S.next(ui + 1, nxt);
        unsigned fl_ = 0u; if constexpr (Sched::MODE == 2) { if (has_next) fl_ = S.flag_load(nxt); }
        if constexpr (Epi::MIDK) { if (has_next) E.prep(nxt, (ui + 1) & 1, tid); }
        if constexpr (GATHER) { if (has_next) { PG8_GATHER_OFFS(nvA, nxt); } else { _Pragma("unroll") for (int h_ = 0; h_ < 2; ++h_) _Pragma("unroll") for (int i_ = 0; i_ < 2; ++i_) nvA[h_][i_] = vA[h_][i_]; } }
        const unsigned nA = GATHER ? 0u : (has_next ? (unsigned)nxt.pm * tstep : cA); const unsigned nB = has_next ? (unsigned)nxt.pn * tstep : cB;
        for (int t = 0; t < nt; t += 2) {
            const bool last = (t == nt - 2);
            const unsigned a1 = cA + (unsigned)(t + 1) * kstep;
            const unsigned a2 = last ? nA : cA + (unsigned)(t + 2) * kstep; const unsigned b2 = last ? nB : cB + (unsigned)(t + 2) * kstep;
            const unsigned a3 = a2 + kstep; const unsigned b3 = b2 + kstep;
            if constexpr (Sched::MODE == 2) { if (last && has_next) S.a_ready_pref(nxt, fl_); }
            else { if (last && has_next) S.a_ready(nxt); }
            if constexpr (SP2) {
            PG8_LDB(B0, 0, 0); PG8_LDB(B1, 0, 1); PG8_SCHED; PG8_LDA(At, 0, 0); PG8_STAGE_A(PG8_SA(1, 1), 1, a1, false);
            PG8_WAIT_V(8); PG8_WAIT_L(0); PG8_BAR; PG8_MMA(0, 0, At, B0); PG8_MMA(0, 1, At, B1); PG8_BAR; PG8_SCHED;
            PG8_LDA(At, 0, 1); PG8_STAGE_R(rsB, PG8_SB(0, 0), b2, voffB); PG8_STAGE_R(rsB, PG8_SB(0, 1), b2 + hstep, voffB); PG8_STAGE_A(PG8_SA(0, 0), 0, a2, last);
            PG8_WAIT_V(8); PG8_WAIT_L(0); PG8_BAR; PG8_MMA(1, 0, At, B0); PG8_MMA(1, 1, At, B1); PG8_BAR; PG8_SCHED;
            PG8_LDB(B0, 1, 0); PG8_LDB(B1, 1, 1); PG8_SCHED; PG8_LDA(At, 1, 0); PG8_STAGE_A(PG8_SA(0, 1), 1, a2, last);
            PG8_WAIT_V(8); PG8_WAIT_L(0); PG8_BAR; PG8_MMA(0, 0, At, B0); PG8_MMA(0, 1, At, B1); PG8_BAR; PG8_SCHED;
            PG8_LDA(At, 1, 1); PG8_STAGE_R(rsB, PG8_SB(1, 0), b3, voffB); PG8_STAGE_R(rsB, PG8_SB(1, 1), b3 + hstep, voffB); PG8_STAGE_A(PG8_SA(1, 0), 0, a3, last);
            PG8_WAIT_V(8); PG8_WAIT_L(0); PG8_BAR; PG8_MMA(1, 0, At, B0); PG8_MMA(1, 1, At, B1); PG8_BAR; PG8_SCHED;
            } else {
            PG8_LDB(B0, 0, 0); PG8_SCHED; PG8_LDA(At, 0, 0); PG8_STAGE_R(rsA, PG8_SA(1, 1), a1 + hstep, voffA);
            PG8_WAIT_L(8); PG8_BAR; PG8_WAIT_L(0); PG8_MMA(0, 0, At, B0); PG8_BAR; PG8_SCHED;
            PG8_LDB(B1, 0, 1); PG8_STAGE_R(rsB, PG8_SB(0, 0), b2, voffB);
            PG8_BAR; PG8_WAIT_L(0); PG8_MMA(0, 1, At, B1); PG8_BAR;
            PG8_LDA(At, 0, 1); PG8_STAGE_R(rsA, PG8_SA(0, 0), a2, voffA);
            PG8_BAR; PG8_WAIT_L(0); PG8_MMA(1, 0, At, B0); PG8_BAR; PG8_SCHED;
            PG8_STAGE_R(rsB, PG8_SB(0, 1), b2 + hstep, voffB);
            PG8_WAIT_V(6); PG8_BAR; PG8_MMA(1, 1, At, B1); PG8_BAR;
            PG8_LDB(B0, 1, 0); PG8_SCHED; PG8_LDA(At, 1, 0); PG8_STAGE_R(rsA, PG8_SA(0, 1), a2 + hstep, voffA);
            PG8_WAIT_L(8); PG8_BAR; PG8_WAIT_L(0); PG8_MMA(0, 0, At, B0); PG8_BAR; PG8_SCHED;
            PG8_LDB(B1, 1, 1); PG8_STAGE_R(rsB, PG8_SB(1, 0), b3, voffB);
            PG8_BAR; PG8_WAIT_L(0); PG8_MMA(0, 1, At, B1); PG8_BAR;
            PG8_LDA(At, 1, 1); PG8_STAGE_R(rsA, PG8_SA(1, 0), a3, voffA);
            PG8_BAR; PG8_WAIT_L(0); PG8_MMA(1, 0, At, B0); PG8_BAR; PG8_SCHED;
            PG8_STAGE_R(rsB, PG8_SB(1, 1), b3 + hstep, voffB);
            PG8_WAIT_V(6); PG8_BAR; PG8_MMA(1, 1, At, B1); PG8_BAR;
            }
            if constexpr (Epi::MIDK) { if (t == nt / 2 - 2) E.midk(acc, ui & 1, wr, fr); }
        }
        if constexpr (ALIGN_EPI) { if (wr == 0) PG8_BAR; }
        if constexpr (Sched::MODE == 1) { if (nt >= 4 && prev_pm >= 0) S.publish(prev_pm); }
        int l_e; asm volatile("v_mbcnt_lo_u32_b32 %0, -1, 0\n\tv_mbcnt_hi_u32_b32 %0, -1, %0" : "=v"(l_e)); const int fr_e = l_e & 15, fq_e = l_e >> 4;
        if constexpr (Epi::MIDK) { E.epi(acc, cur, ui & 1, wr, wc, fr_e, fq_e); S.done(cur); }
        else if constexpr (!Epi::AFTER_DRAIN) { E(acc, cur, wr, wc, fr_e, fq_e); S.done(cur); }
        if constexpr (Sched::MODE == 1) { if (nt < 4) { PG8_WAIT_V(0); S.publish(cur.pm); } else prev_pm = cur.pm; }
        if (!has_next) break;
#pragma unroll
        for (int a = 0; a < 2; ++a)
#pragma unroll
            for (int b = 0; b < 2; ++b)
#pragma unroll
                for (int m = 0; m < 4; ++m)
#pragma unroll
                    for (int n = 0; n < 2; ++n) { acc[a][b][m][n] = (f32x4){0.f, 0.f, 0.f, 0.f}; if constexpr (FP8) asm volatile("" : "+v"(acc[a][b][m][n])); }
        cur = nxt; cA = nA; cB = nB; ++ui;
        if constexpr (GATHER) { _Pragma("unroll") for (int h_ = 0; h_ < 2; ++h_) _Pragma("unroll") for (int i_ = 0; i_ < 2; ++i_) vA[h_][i_] = nvA[h_][i_]; }
        if constexpr (ALIGN_EPI) { if (wr == 1) PG8_BAR; }
    }
    PG8_WAIT_V(0);
    if constexpr (Sched::MODE == 1) { if (prev_pm >= 0) S.publish(prev_pm); }
    if constexpr (!ALIGN_EPI) { if (wr == 0) PG8_BAR; }
    PG8_BAR;
    if constexpr (Epi::AFTER_DRAIN) { E.fused(acc, cur, wr, wc, fr, fq, lds, wid, lane); S.done(cur); }
#undef PG8_SA
#undef PG8_SB
#undef PG8_STAGE_R
#undef PG8_STAGE2
#undef PG8_STAGE_A
#undef PG8_GATHER_OFFS
#undef PG8_LDA
#undef PG8_LDB
#undef PG8_MMA
#undef PG8_CAT8
#undef PG8_WAIT_V
#undef PG8_WAIT_L
#undef PG8_BAR
#undef PG8_SCHED
}
}

namespace att {
typedef short bf16x8 __attribute__((ext_vector_type(8)));
typedef short s16x4 __attribute__((ext_vector_type(4)));
typedef float f32x16 __attribute__((ext_vector_type(16)));
typedef float f32x4 __attribute__((ext_vector_type(4)));
typedef unsigned u32x4 __attribute__((ext_vector_type(4)));
typedef unsigned u32x2 __attribute__((ext_vector_type(2)));
typedef short v4i16_t __attribute__((ext_vector_type(4)));
typedef __attribute__((address_space(3))) const char* lds_cptr;
constexpr int DM = 1024, SLOTB = 8192;
constexpr int NSLOT = 8, DIST = 4;
constexpr int L_K = 0, L_V = NSLOT * SLOTB, L_B = 2 * NSLOT * SLOTB, L_DONE = L_B + NSLOT * 256, L_BYTES = L_DONE + 64;
constexpr float FOX_THR = 40.f, SB_THR = 32.f;
__device__ __forceinline__ int crow(int r, int hi) { return (r & 3) + 8 * (r >> 2) + 4 * hi; }
__device__ __forceinline__ void glds16(const void* gsrc, unsigned lds_dst) { unsigned keep;
    asm volatile("s_mov_b32 %0, m0\n\ts_mov_b32 m0, %2\n\ts_nop 0\n\tglobal_load_lds_dwordx4 %1, off\n\ts_mov_b32 m0, %0" : "=&s"(keep) : "v"(gsrc), "s"(lds_dst) : "memory"); }
__device__ __forceinline__ void glds4(const void* gsrc, unsigned lds_dst) { unsigned keep;
    asm volatile("s_mov_b32 %0, m0\n\ts_mov_b32 m0, %2\n\ts_nop 0\n\tglobal_load_lds_dword %1, off\n\ts_mov_b32 m0, %0" : "=&s"(keep) : "v"(gsrc), "s"(lds_dst) : "memory"); }
typedef float f32x2_t __attribute__((ext_vector_type(2))); typedef __bf16 bf16x2_t __attribute__((ext_vector_type(2)));
__device__ __forceinline__ unsigned cvtpk(float lo, float hi) { f32x2_t v = {lo, hi}; bf16x2_t b = __builtin_convertvector(v, bf16x2_t); return __builtin_bit_cast(unsigned, b); }
__device__ __forceinline__ s16x4 vtr(lds_cptr p) { return __builtin_bit_cast(s16x4, __builtin_amdgcn_ds_read_tr16_b64_v4i16((__attribute__((address_space(3))) v4i16_t*)p)); }
#define ATT_WAIT_BAR() asm volatile("s_waitcnt vmcnt(0) lgkmcnt(0)\n\ts_barrier" ::: "memory")
#define ATT_BAR() asm volatile("s_barrier" ::: "memory")
#define ATT_LBAR() asm volatile("s_waitcnt lgkmcnt(0)\n\ts_barrier" ::: "memory")
#define ATT_WAITV_BAR(n) asm volatile("s_waitcnt vmcnt(" #n ") lgkmcnt(0)\n\ts_barrier" ::: "memory")
__device__ __forceinline__ float max3f(float a, float b, float c) { float r; asm("v_max3_f32 %0, %1, %2, %3" : "=v"(r) : "v"(a), "v"(b), "v"(c)); return r; }

constexpr int G_SLOTS = 4;
constexpr int G_K = 0, G_V = G_SLOTS * SLOTB, G_B = 2 * G_SLOTS * SLOTB, G_DONE = G_B + G_SLOTS * 256, G_ARR = G_DONE + 64, G_BYTES = G_ARR + 64;
typedef volatile __attribute__((address_space(3))) unsigned* lds_vu32;
__device__ __forceinline__ void grp_barrier(lds_vu32 arr, unsigned& epoch, int wid, int lane) {
    ++epoch;
    if (lane == 0) arr[wid] = epoch;
    for (;;) { const unsigned v = (lane < 4) ? arr[lane] : epoch; if (__all(v >= epoch)) break; __builtin_amdgcn_s_sleep(0); }
    asm volatile("" ::: "memory");
}
#define G_WAITV(n) asm volatile("s_waitcnt vmcnt(" #n ") lgkmcnt(0)" ::: "memory")
template <bool FOX, bool PRUNE>
__device__ __forceinline__ void attn_unit4(int b, int h16, int qb, const bf16* QO, bf16* F_O, const bf16* __restrict__ K, const bf16* __restrict__ V, float* SSQ, const float* CLrow, float KN, char* shm, unsigned& epoch) {
    const int tid = threadIdx.x, lane = tid & 63, r32 = lane & 31, hi = lane >> 5; const int wid = __builtin_amdgcn_readfirstlane((tid >> 6) & 3);
    const long rowbase = (long)b * SEQ; const int q0 = qb * 128;
    const bf16* Qw = QO + (rowbase + q0 + wid * 32) * DM + h16 * 64;
    const bf16* Kh = K + rowbase * DM + h16 * 64; const bf16* Vh = V + rowbase * DM + h16 * 64;
    const unsigned lds0 = (unsigned)(uintptr_t)shm;
    const bf16* ksrc = Kh + (long)(8 * wid + (lane >> 3)) * DM + (((lane & 7) ^ (lane >> 3)) * 8);
    const bf16* vsrc = Vh + (long)(16 * wid + (lane >> 2)) * DM + (lane & 3) * 8;
    const unsigned kdst = lds0 + G_K + wid * 1024, vdst = lds0 + G_V + wid * 1024, bdst = lds0 + G_B;
    const lds_cptr shm3 = (lds_cptr)shm;
    const lds_cptr kp0 = shm3 + G_K + r32 * 128; const int kx = ((r32 & 7) ^ hi) << 4;
    const lds_cptr vp0 = shm3 + G_V + ((lane >> 4) & 1) * 32 + (lane & 3) * 8 + (4 * hi + ((lane & 15) >> 2)) * 64;
    volatile __attribute__((address_space(3))) int* done_at = (volatile __attribute__((address_space(3))) int*)(shm3 + G_DONE);
    lds_vu32 arr = (lds_vu32)(shm3 + G_ARR);
    const int NT = (q0 + 128) / 64;
#define G_DMA(t, slot) do { glds16(ksrc + (long)(t) * 64 * DM, (unsigned)__builtin_amdgcn_readfirstlane(kdst + (slot) * SLOTB)); glds16(ksrc + (long)((t) * 64 + 32) * DM, (unsigned)__builtin_amdgcn_readfirstlane(kdst + 4096 + (slot) * SLOTB)); \
        glds16(vsrc + (long)(t) * 64 * DM, (unsigned)__builtin_amdgcn_readfirstlane(vdst + (slot) * SLOTB)); glds16(vsrc + (long)(t) * 64 * DM + 32, (unsigned)__builtin_amdgcn_readfirstlane(vdst + 4096 + (slot) * SLOTB)); \
        if (FOX) glds4(CLrow + (t) * 64 + lane, (unsigned)__builtin_amdgcn_readfirstlane(bdst + (slot) * 256)); } while (0)
    bf16x8 qr[4];
#pragma unroll
    for (int d0 = 0; d0 < 4; ++d0) qr[d0] = *reinterpret_cast<const bf16x8*>(&Qw[(long)r32 * DM + d0 * 16 + hi * 8]);
    float qn = 0.f;
    if (FOX && PRUNE) {
#pragma unroll
        for (int d0 = 0; d0 < 4; ++d0)
#pragma unroll
            for (int j = 0; j < 8; ++j) { const float v = __builtin_bit_cast(float, (unsigned)(unsigned short)qr[d0][j] << 16); qn += v * v; }
        qn += __shfl_xor(qn, 32); qn = sqrtf(qn) * KN;
    }
    const float clref = FOX ? CLrow[q0 + wid * 32] : 0.f;
    const int qrel = wid * 32 + r32;
    asm volatile("" :: "v"(qr[0]), "v"(qr[1]), "v"(qr[2]), "v"(qr[3]), "v"(clref), "v"(qn));
    G_WAITV(0); grp_barrier(arr, epoch, wid, lane);
    if (lane == 0) done_at[wid] = 0x7fffffff;
    G_DMA(NT - 1, 0); G_DMA(NT - 2, 1); if (NT >= 3) G_DMA(NT - 3, 2);
    f32x16 o0 = {}, o1 = {}, lacc = {};
    float mref = 0.f, R = 0.f;
    bool mydone = false, posted = false, first = true;
    bf16x8 U0, U1, ONES;
#pragma unroll
    for (int j = 0; j < 8; ++j) { const int kk = 8 * (j >> 2) + 4 * hi + (j & 3); U0[j] = (kk > r32) ? (short)0x3f80 : (short)0; U1[j] = (16 + kk > r32) ? (short)0x3f80 : (short)0; ONES[j] = (short)0x3f80; }
    for (int i = 0;; ++i) {
        const int t = NT - 1 - i, slot = i & (G_SLOTS - 1);
        if (t < 0) break;
        { const int ahead = t < 2 ? t : 2;
          if (FOX) { if (ahead == 2) G_WAITV(10); else if (ahead == 1) G_WAITV(5); else G_WAITV(0); }
          else     { if (ahead == 2) G_WAITV(8); else if (ahead == 1) G_WAITV(4); else G_WAITV(0); } }
        grp_barrier(arr, epoch, wid, lane);
        if (i > 0) { const int da = done_at[lane & 3]; if (__all(da <= i - 1)) break; }
        if (t >= 3) G_DMA(t - 3, (i + 3) & (G_SLOTS - 1));
        const int jb = t - (NT - 2);
        if (!mydone && !(jb >= 0 && 2 * jb > wid)) {
            const lds_cptr kp = kp0 + slot * SLOTB; const lds_cptr vp = vp0 + slot * SLOTB;
            bf16x8 kf[8];
#pragma unroll
            for (int d0 = 0; d0 < 4; ++d0) { const int ko = kx ^ (d0 << 5); kf[2 * d0] = *(const __attribute__((address_space(3))) bf16x8*)(kp + ko); kf[2 * d0 + 1] = *(const __attribute__((address_space(3))) bf16x8*)(kp + ko + 4096); }
            const bool need_mask = __builtin_amdgcn_readfirstlane((int)(jb >= 0 && 64 * jb + 63 > 32 * wid)) != 0;
            f32x16 p0, p1; float bias00 = 0.f;
            if (FOX) {
                const __attribute__((address_space(3))) f32x4* bp = (const __attribute__((address_space(3))) f32x4*)(shm3 + G_B + slot * 256);
                const float cm = clref - mref;
#pragma unroll
                for (int g = 0; g < 4; ++g) { const f32x4 c0 = bp[2 * g + hi], c1 = bp[8 + 2 * g + hi];
#pragma unroll
                    for (int e = 0; e < 4; ++e) { p0[4 * g + e] = cm - c0[e]; p1[4 * g + e] = cm - c1[e]; } }
                bias00 = clref - bp[0][0];
            } else { p0 = f32x16{}; p1 = f32x16{}; }
#pragma unroll
            for (int d0 = 0; d0 < 4; ++d0) { p0 = __builtin_amdgcn_mfma_f32_32x32x16_bf16(kf[2 * d0], qr[d0], p0, 0, 0, 0); p1 = __builtin_amdgcn_mfma_f32_32x32x16_bf16(kf[2 * d0 + 1], qr[d0], p1, 0, 0, 0); }
            s16x4 vlo[8], vhi[8];
#pragma unroll
            for (int q = 0; q < 8; ++q) { vlo[q] = vtr(vp + ((q >> 2) * 4096 + (q & 3) * 1024)); vhi[q] = vtr(vp + ((q >> 2) * 4096 + (q & 3) * 1024 + 512)); }
            if (FOX) asm volatile("s_nop 15\n\ts_nop 7" : "+v"(p0), "+v"(p1));
            if (FOX) {
                if (need_mask) { asm volatile("" ::: "memory");
#pragma unroll
                    for (int r = 0; r < 16; ++r) { const int kv = 64 * jb + crow(r, hi); if (kv > qrel) p0[r] = -INFINITY; if (kv + 32 > qrel) p1[r] = -INFINITY; } }
                float ma = max3f(p0[0], p1[0], p0[1]), mb = max3f(p1[1], p0[2], p1[2]);
#pragma unroll
                for (int r = 3; r < 15; r += 2) { ma = max3f(ma, p0[r], p1[r]); mb = max3f(mb, p0[r + 1], p1[r + 1]); }
                ma = max3f(ma, p0[15], p1[15]);
                float mt = max3f(ma, mb, mb); mt = max3f(mt, __shfl_xor(mt, 32), mt);
                if (first || __any(mt > 0.f)) {
                    const float d = first ? mt : fmaxf(mt, 0.f); mref += d;
                    if (!first) { const float alpha = __builtin_amdgcn_exp2f(-d);
#pragma unroll
                        for (int r = 0; r < 16; ++r) { o0[r] *= alpha; o1[r] *= alpha; }
                        lacc[0] *= alpha; }
#pragma unroll
                    for (int r = 0; r < 16; ++r) { p0[r] -= d; p1[r] -= d; }
                    first = false;
                }
#pragma unroll
                for (int r = 0; r < 16; ++r) { p0[r] = __builtin_amdgcn_exp2f(p0[r]); p1[r] = __builtin_amdgcn_exp2f(p1[r]); }
                if (t == 0) mydone = true;
                else if (PRUNE) mydone = __all(qn + bias00 - mref < -FOX_THR);
            } else {
                f32x16 x0, x1;
#pragma unroll
                for (int r = 0; r < 16; ++r) {
                    { const float z = p0[r]; const float sp = __builtin_amdgcn_logf(1.f + __builtin_amdgcn_exp2f(-fabsf(z))); const float lb = fminf(z, 0.f) - sp; p0[r] = lb; x0[r] = lb - z; }
                    { const float z = p1[r]; const float sp = __builtin_amdgcn_logf(1.f + __builtin_amdgcn_exp2f(-fabsf(z))); const float lb = fminf(z, 0.f) - sp; p1[r] = lb; x1[r] = lb - z; } }
                if (need_mask) { asm volatile("" ::: "memory");
#pragma unroll
                    for (int r = 0; r < 16; ++r) { const int kv = 64 * jb + crow(r, hi); if (kv >= qrel) { p0[r] = -INFINITY; x0[r] = 0.f; } if (kv + 32 >= qrel) { p1[r] = -INFINITY; x1[r] = 0.f; } } }
                u32x4 xw0, xw1, xw2, xw3;
                xw0 = (u32x4){cvtpk(x0[0], x0[1]), cvtpk(x0[2], x0[3]), cvtpk(x0[4], x0[5]), cvtpk(x0[6], x0[7])}; xw1 = (u32x4){cvtpk(x0[8], x0[9]), cvtpk(x0[10], x0[11]), cvtpk(x0[12], x0[13]), cvtpk(x0[14], x0[15])};
                xw2 = (u32x4){cvtpk(x1[0], x1[1]), cvtpk(x1[2], x1[3]), cvtpk(x1[4], x1[5]), cvtpk(x1[6], x1[7])}; xw3 = (u32x4){cvtpk(x1[8], x1[9]), cvtpk(x1[10], x1[11]), cvtpk(x1[12], x1[13]), cvtpk(x1[14], x1[15])};
                p1 = __builtin_amdgcn_mfma_f32_32x32x16_bf16(U0, __builtin_bit_cast(bf16x8, xw2), p1, 0, 0, 0);
                p1 = __builtin_amdgcn_mfma_f32_32x32x16_bf16(U1, __builtin_bit_cast(bf16x8, xw3), p1, 0, 0, 0);
                p0 = __builtin_amdgcn_mfma_f32_32x32x16_bf16(U0, __builtin_bit_cast(bf16x8, xw0), p0, 0, 0, 0);
                p0 = __builtin_amdgcn_mfma_f32_32x32x16_bf16(U1, __builtin_bit_cast(bf16x8, xw1), p0, 0, 0, 0);
                p0 = __builtin_amdgcn_mfma_f32_32x32x16_bf16(ONES, __builtin_bit_cast(bf16x8, xw2), p0, 0, 0, 0);
                p0 = __builtin_amdgcn_mfma_f32_32x32x16_bf16(ONES, __builtin_bit_cast(bf16x8, xw3), p0, 0, 0, 0);
                f32x16 tt = __builtin_amdgcn_mfma_f32_32x32x16_bf16(ONES, __builtin_bit_cast(bf16x8, xw0), f32x16{}, 0, 0, 0);
                tt = __builtin_amdgcn_mfma_f32_32x32x16_bf16(ONES, __builtin_bit_cast(bf16x8, xw1), tt, 0, 0, 0);
                tt = __builtin_amdgcn_mfma_f32_32x32x16_bf16(ONES, __builtin_bit_cast(bf16x8, xw2), tt, 0, 0, 0);
                tt = __builtin_amdgcn_mfma_f32_32x32x16_bf16(ONES, __builtin_bit_cast(bf16x8, xw3), tt, 0, 0, 0);
#pragma unroll
                for (int r = 0; r < 16; ++r) { p0[r] = __builtin_amdgcn_exp2f(p0[r] + R); p1[r] = __builtin_amdgcn_exp2f(p1[r] + R); }
                R += tt[0];
                if (t == 0) mydone = true;
                else if (PRUNE) mydone = __all(R < -SB_THR);
            }
            u32x4 pw0, pw1, pw2, pw3;
            pw0 = (u32x4){cvtpk(p0[0], p0[1]), cvtpk(p0[2], p0[3]), cvtpk(p0[4], p0[5]), cvtpk(p0[6], p0[7])}; pw1 = (u32x4){cvtpk(p0[8], p0[9]), cvtpk(p0[10], p0[11]), cvtpk(p0[12], p0[13]), cvtpk(p0[14], p0[15])};
            pw2 = (u32x4){cvtpk(p1[0], p1[1]), cvtpk(p1[2], p1[3]), cvtpk(p1[4], p1[5]), cvtpk(p1[6], p1[7])}; pw3 = (u32x4){cvtpk(p1[8], p1[9]), cvtpk(p1[10], p1[11]), cvtpk(p1[12], p1[13]), cvtpk(p1[14], p1[15])};
#define G_PV(OACC, DH, KS, PW) do { const bf16x8 vf_ = (bf16x8){vlo[(DH) * 4 + (KS)][0], vlo[(DH) * 4 + (KS)][1], vlo[(DH) * 4 + (KS)][2], vlo[(DH) * 4 + (KS)][3], vhi[(DH) * 4 + (KS)][0], vhi[(DH) * 4 + (KS)][1], vhi[(DH) * 4 + (KS)][2], vhi[(DH) * 4 + (KS)][3]}; \
                OACC = __builtin_amdgcn_mfma_f32_32x32x16_bf16(vf_, __builtin_bit_cast(bf16x8, PW), OACC, 0, 0, 0); } while (0)
            G_PV(o0, 0, 0, pw0); G_PV(o1, 1, 0, pw0); G_PV(o0, 0, 1, pw1); G_PV(o1, 1, 1, pw1);
            G_PV(o0, 0, 2, pw2); G_PV(o1, 1, 2, pw2); G_PV(o0, 0, 3, pw3); G_PV(o1, 1, 3, pw3);
#undef G_PV
            if (FOX) { lacc = __builtin_amdgcn_mfma_f32_32x32x16_bf16(ONES, __builtin_bit_cast(bf16x8, pw0), lacc, 0, 0, 0); lacc = __builtin_amdgcn_mfma_f32_32x32x16_bf16(ONES, __builtin_bit_cast(bf16x8, pw1), lacc, 0, 0, 0);
                       lacc = __builtin_amdgcn_mfma_f32_32x32x16_bf16(ONES, __builtin_bit_cast(bf16x8, pw2), lacc, 0, 0, 0); lacc = __builtin_amdgcn_mfma_f32_32x32x16_bf16(ONES, __builtin_bit_cast(bf16x8, pw3), lacc, 0, 0, 0); }
        }
        if (t == 0) mydone = true;
        if (mydone && !posted) { if (lane == 0) done_at[wid] = i; posted = true; }
    }
#undef G_DMA
    float inv = 1.f;
    if (FOX) inv = 1.f / lacc[0];
    float ssq = 0.f;
#pragma unroll
    for (int r = 0; r < 16; ++r) { o0[r] *= inv; o1[r] *= inv; ssq += o0[r] * o0[r] + o1[r] * o1[r]; }
    ssq += __shfl_xor(ssq, 32);
    if (hi == 0) SSQ[(size_t)(rowbase + q0 + qrel) * 16 + h16] = ssq;
    bf16* orow = F_O + (rowbase + q0 + wid * 32 + r32) * DM + h16 * 64;
#pragma unroll
    for (int g = 0; g < 4; ++g) {
        u32x2 w0 = {cvtpk(o0[4 * g], o0[4 * g + 1]), cvtpk(o0[4 * g + 2], o0[4 * g + 3])}, w1 = {cvtpk(o1[4 * g], o1[4 * g + 1]), cvtpk(o1[4 * g + 2], o1[4 * g + 3])};
        *(u32x2*)(orow + 8 * g + 4 * hi) = w0; *(u32x2*)(orow + 32 + 8 * g + 4 * hi) = w1; }
}
#undef G_WAITV
}

#define XB_TMO      128
#define XB_XCNT(j)  (256  + 64 * (j))
#define XB_XSUB(j)  (1280 + 64 * (j))
#define XB_XGEN(j)  (2304 + 64 * (j))
#define XB_TOP      3328
#define XB_TOPGEN   3392
#define XCD_BAR_WORDS 3456
#define XB_SPIN_CAP (1u << 21)
__device__ __forceinline__ unsigned xb_ld(unsigned* p)              { return __hip_atomic_load(p, __ATOMIC_RELAXED, __HIP_MEMORY_SCOPE_AGENT); }
__device__ __forceinline__ unsigned xb_add(unsigned* p, unsigned v) { return __hip_atomic_fetch_add(p, v, __ATOMIC_RELAXED, __HIP_MEMORY_SCOPE_AGENT); }
__device__ __forceinline__ unsigned xb_xcc_id() { return (unsigned)__builtin_amdgcn_s_getreg((3 << 11) | 20) & 0xFu; }
#define XB_SPIN(cond, bar) do { unsigned _sp = 0; while (cond) { __builtin_amdgcn_s_sleep(1); \
    if ((++_sp & 255u) == 0u) { if (xb_ld(&(bar)[XB_TMO])) break; if (_sp > XB_SPIN_CAP) { atomicAdd(&(bar)[XB_TMO], 1u); break; } } } } while (0)
struct XcdBarrier { unsigned* bar; unsigned x; volatile LAS unsigned* st; };
__device__ __forceinline__ XcdBarrier xcd_barrier_post(unsigned* bar, volatile LAS unsigned* st) {
    XcdBarrier b; b.bar = bar; b.x = xb_xcc_id(); b.st = st;
    if (threadIdx.x == 0) (void)xb_add(&bar[XB_XCNT(b.x)], 1u);
    return b;
}
__device__ __forceinline__ void xcd_barrier_complete(unsigned* bar, unsigned x, unsigned& nloc, unsigned& nx) {
    const unsigned G = gridDim.x * gridDim.y * gridDim.z;
    unsigned sum, cnt, mine, sp = 0u;
    for (;;) {
        sum = 0u; cnt = 0u; mine = 0u;
#pragma unroll
        for (unsigned j = 0; j < 16; ++j) { const unsigned c = xb_ld(&bar[XB_XCNT(j)]); sum += c; cnt += (c > 0u) ? 1u : 0u; mine = (j == x) ? c : mine; }
        if (sum == G) break;
        __builtin_amdgcn_s_sleep(1);
        if ((++sp & 255u) == 0u) { if (xb_ld(&bar[XB_TMO])) break; if (sp > XB_SPIN_CAP) { atomicAdd(&bar[XB_TMO], 1u); break; } }
    }
    nloc = mine > 0u ? mine : 1u; nx = cnt > 0u ? cnt : 1u;
}
__device__ __forceinline__ void xcd_barrier_proto(const XcdBarrier& b) {
    {
        unsigned* bar = b.bar;
        __builtin_amdgcn_s_waitcnt(0);
        unsigned nloc = b.st[0], nx = b.st[1];
        if (nloc == 0u) { xcd_barrier_complete(bar, b.x, nloc, nx); b.st[0] = nloc; b.st[1] = nx; }
        const unsigned old = xb_add(&bar[XB_XSUB(b.x)], 1u);
        const unsigned gen = old / nloc;
        if (old + 1u == (gen + 1u) * nloc) {
            __builtin_amdgcn_fence(__ATOMIC_RELEASE, "agent");
            asm volatile("s_waitcnt vmcnt(0)" ::: "memory");
            const unsigned og = xb_add(&bar[XB_TOP], 1u);
            const unsigned tg = og / nx;
            if (og + 1u == (tg + 1u) * nx) xb_add(&bar[XB_TOPGEN], 1u);
            else XB_SPIN(xb_ld(&bar[XB_TOPGEN]) == tg, bar);
            __builtin_amdgcn_fence(__ATOMIC_ACQUIRE, "agent");
            xb_add(&bar[XB_XGEN(b.x)], 1u);
            asm volatile("s_waitcnt vmcnt(0)" ::: "memory");
        } else {
            XB_SPIN(xb_ld(&bar[XB_XGEN(b.x)]) == gen, bar);
            __builtin_amdgcn_fence(__ATOMIC_ACQUIRE, "agent");
            asm volatile("s_waitcnt vmcnt(0)" ::: "memory");
        }
    }
}
__device__ __forceinline__ void xcd_barrier(const XcdBarrier& b) {
    asm volatile("s_waitcnt vmcnt(0)" ::: "memory");
    __syncthreads();
    if (threadIdx.x == 0) xcd_barrier_proto(b);
    __syncthreads();
}
template <class Work>
__device__ __forceinline__ void xcd_barrier_work(const XcdBarrier& b, Work work) {
    asm volatile("s_waitcnt vmcnt(0)" ::: "memory");
    __syncthreads();
    if (threadIdx.x < 64) { if (threadIdx.x == 0) xcd_barrier_proto(b); }
    else work();
    __syncthreads();
}

struct Args { const float* in[15]; float* out; unsigned char* ws; int ph_lo, ph_hi; };
__device__ __forceinline__ int hw_lane() { return (int)__builtin_amdgcn_mbcnt_hi(~0u, __builtin_amdgcn_mbcnt_lo(~0u, 0u)); }
struct Frame {
    LAS unsigned char* lds; int tid, wave, G, bid;
    const float *x, *g_attn, *w_in, *b_forget, *g_fox, *g_sb, *w_out, *g_ffn, *w_router, *b_router, *w_gu, *b_gu, *w_d, *b_d, *g_final;
    float* out; unsigned char* ws;
};

typedef float f32x2_g __attribute__((ext_vector_type(2))); typedef __bf16 bf16x2_g __attribute__((ext_vector_type(2)));
__device__ __forceinline__ unsigned cvtpk2(float lo, float hi) { f32x2_g v = {lo, hi}; bf16x2_g r = __builtin_convertvector(v, bf16x2_g); return __builtin_bit_cast(unsigned, r); }
__device__ __forceinline__ void transpose_item(const float* W, int ldw, int K, bf16* WT, int item, int nblk, LAS unsigned* scr, int lane, const float* ks = nullptr, const float* ks2 = nullptr) {
    const int kb = item / nblk, nb = item % nblk, k0 = 64 * kb, n0 = 64 * nb, ng = lane & 15, kp = lane >> 4;
    f32x4 a[8], b[8];
#pragma unroll
    for (int i = 0; i < 8; ++i) { const float* p = W + (size_t)(k0 + 8 * i + 2 * kp) * ldw + n0 + 4 * ng; a[i] = __builtin_nontemporal_load((const f32x4*)p); b[i] = __builtin_nontemporal_load((const f32x4*)(p + ldw)); }
    if (ks) { const float* kq = (k0 < 512) ? ks + k0 : ks2 + (k0 - 512);
#pragma unroll
        for (int i = 0; i < 8; ++i) { a[i] = a[i] * kq[8 * i + 2 * kp]; b[i] = b[i] * kq[8 * i + 2 * kp + 1]; } }
#pragma unroll
    for (int i = 0; i < 8; ++i)
#pragma unroll
        for (int j = 0; j < 4; ++j) scr[(4 * ng + j) * 34 + 4 * i + kp] = cvtpk2(a[i][j], b[i][j]);
    LDS_WAIT(); asm volatile("" ::: "memory");
    const int c = lane & 7, rr = lane >> 3;
#pragma unroll
    for (int g = 0; g < 8; ++g) { const int n = 8 * g + rr; const v2u lo = *(const LAS v2u*)(scr + n * 34 + 4 * c), hi = *(const LAS v2u*)(scr + n * 34 + 4 * c + 2);
        *(GAS v4u*)(WT + (size_t)(n0 + n) * K + k0 + 8 * c) = (v4u){lo.x, lo.y, hi.x, hi.y}; }
    LDS_WAIT(); asm volatile("" ::: "memory");
}
__device__ __forceinline__ void transpose_item_fp8(const float* W, int ldw, int K, unsigned char* WT, int item, int nblk, LAS unsigned* scr, int lane, float scale) {
    const int kb = item / nblk, nb = item % nblk, k0 = 128 * kb, n0 = 32 * nb, ng = lane & 7, kq = lane >> 3;
    f32x4 r[4][4];
#pragma unroll
    for (int i = 0; i < 4; ++i)
#pragma unroll
        for (int q = 0; q < 4; ++q) r[i][q] = __builtin_nontemporal_load((const f32x4*)(W + (size_t)(k0 + 32 * i + 4 * kq + q) * ldw + n0 + 4 * ng));
#pragma unroll
    for (int i = 0; i < 4; ++i)
#pragma unroll
        for (int j = 0; j < 4; ++j) scr[(4 * ng + j) * 34 + 8 * i + kq] = pg8::cvt4_fp8(r[i][0][j] * scale, r[i][1][j] * scale, r[i][2][j] * scale, r[i][3][j] * scale);
    LDS_WAIT(); asm volatile("" ::: "memory");
    const int c = lane & 7, rr = lane >> 3;
#pragma unroll
    for (int g = 0; g < 4; ++g) { const int n = rr + 8 * g; const v2u lo = *(const LAS v2u*)(scr + n * 34 + 4 * c), hi = *(const LAS v2u*)(scr + n * 34 + 4 * c + 2);
        *(GAS v4u*)(WT + (size_t)(n0 + n) * K + k0 + 16 * c) = (v4u){lo.x, lo.y, hi.x, hi.y}; }
    LDS_WAIT(); asm volatile("" ::: "memory");
}
__device__ __forceinline__ void transpose_pair_fp8(const float* W, int ldw, int K, unsigned char* WT, int item, int nblk, LAS unsigned* scr, int lane, float scale) {
    const int kb = item / nblk, nb = item % nblk, k0 = 128 * kb, n0 = 32 * nb, ng = lane & 7, kq = lane >> 3;
    f32x4 ra[4][4], rb[4][4];
#pragma unroll
    for (int i = 0; i < 4; ++i)
#pragma unroll
        for (int q = 0; q < 4; ++q) ra[i][q] = __builtin_nontemporal_load((const f32x4*)(W + (size_t)(k0 + 32 * i + 4 * kq + q) * ldw + n0 + 4 * ng));
#pragma unroll
    for (int i = 0; i < 4; ++i)
#pragma unroll
        for (int q = 0; q < 4; ++q) rb[i][q] = __builtin_nontemporal_load((const f32x4*)(W + (size_t)(k0 + 32 * i + 4 * kq + q) * ldw + n0 + 32 + 4 * ng));
    const int c = lane & 7, rr = lane >> 3;
#pragma unroll
    for (int i = 0; i < 4; ++i)
#pragma unroll
        for (int j = 0; j < 4; ++j) scr[(4 * ng + j) * 34 + 8 * i + kq] = pg8::cvt4_fp8(ra[i][0][j] * scale, ra[i][1][j] * scale, ra[i][2][j] * scale, ra[i][3][j] * scale);
    LDS_WAIT(); asm volatile("" ::: "memory");
#pragma unroll
    for (int g = 0; g < 4; ++g) { const int n = rr + 8 * g; const v2u lo = *(const LAS v2u*)(scr + n * 34 + 4 * c), hi = *(const LAS v2u*)(scr + n * 34 + 4 * c + 2);
        *(GAS v4u*)(WT + (size_t)(n0 + n) * K + k0 + 16 * c) = (v4u){lo.x, lo.y, hi.x, hi.y}; }
    LDS_WAIT(); asm volatile("" ::: "memory");
#pragma unroll
    for (int i = 0; i < 4; ++i)
#pragma unroll
        for (int j = 0; j < 4; ++j) scr[(4 * ng + j) * 34 + 8 * i + kq] = pg8::cvt4_fp8(rb[i][0][j] * scale, rb[i][1][j] * scale, rb[i][2][j] * scale, rb[i][3][j] * scale);
    LDS_WAIT(); asm volatile("" ::: "memory");
#pragma unroll
    for (int g = 0; g < 4; ++g) { const int n = rr + 8 * g; const v2u lo = *(const LAS v2u*)(scr + n * 34 + 4 * c), hi = *(const LAS v2u*)(scr + n * 34 + 4 * c + 2);
        *(GAS v4u*)(WT + (size_t)(n0 + 32 + n) * K + k0 + 16 * c) = (v4u){lo.x, lo.y, hi.x, hi.y}; }
    LDS_WAIT(); asm volatile("" ::: "memory");
}
__device__ __forceinline__ void p0_prologue(Frame& F) {
    LAS unsigned* scr = (LAS unsigned*)(F.lds + F.wave * 16384);
    const int gw = F.bid * NWAVES + F.wave, NGW = F.G * NWAVES;
    bf16* Win_t = (bf16*)(F.ws + WS_WIN); bf16* Wout_t = (bf16*)(F.ws + WS_WOUT); bf16* Wgu_t = (bf16*)(F.ws + WS_WGU); bf16* Wd_t = (bf16*)(F.ws + WS_WD);
    constexpr int I_IN = 16 * 8, I_OUT = 16 * 16, I_GU = 8 * 64, I_D = 8 * 32;
    constexpr int NITEMS = 6 * I_IN + I_OUT;
    for (int it = gw; it < NITEMS; it += NGW) {
        int r = it;
        if (r < 6 * I_IN) { const int seg = r / I_IN; r -= seg * I_IN;
            const int src = (seg == 0) ? 0 : (seg == 1) ? 1544 : (seg == 2) ? 512 : (seg == 3) ? 2056 : (seg == 4) ? 1024 : 2568;
            transpose_item(F.w_in + src, INC, D, Win_t + (size_t)seg * 512 * D, r, 8, scr, hw_lane(), F.g_attn, F.g_attn + 512); continue; }
        r -= 6 * I_IN;
        transpose_item(F.w_out, D, D, Wout_t, r, 16, scr, hw_lane(), F.g_fox, F.g_sb);
    }
    __syncthreads();
    LAS float* Wf = (LAS float*)F.lds;
    for (int i = F.tid; i < D * 8; i += NTHR) Wf[i] = F.w_in[(size_t)(i >> 3) * INC + 1536 + (i & 7)];
    __syncthreads();
    bf16* XN = (bf16*)(F.ws + WS_XN); float* LOGF = (float*)(F.ws + WS_LOGF); float* RS0 = (float*)(F.ws + WS_RS0);
    { const int ln = hw_lane();
      const float bfg = F.b_forget[ln & 7];
      f32x4 gq[4], v[4], nv[4];
#pragma unroll
      for (int j = 0; j < 4; ++j) { gq[j] = *((const GAS f32x4*)F.g_attn + ln + 64 * j); nv[j] = (f32x4){0.f, 0.f, 0.f, 0.f}; }
      if (gw < M) { const GAS f32x4* xr = (const GAS f32x4*)(F.x + (size_t)gw * D) + ln;
#pragma unroll
          for (int j = 0; j < 4; ++j) v[j] = xr[64 * j]; }
      float s = 0.f;
#pragma unroll
      for (int j = 0; j < 4; ++j) s += (v[j].x * v[j].x + v[j].y * v[j].y) + (v[j].z * v[j].z + v[j].w * v[j].w);
      for (int m = gw; m < M; m += NGW) {
        { const int mn = (m + NGW < M) ? m + NGW : m;
          const GAS f32x4* xr = (const GAS f32x4*)(F.x + (size_t)mn * D) + ln;
#pragma unroll
          for (int j = 0; j < 4; ++j) nv[j] = xr[64 * j]; }
        const float rs = 1.0f / sqrtf(wave_sum(s) * (1.f / D) + EPS);
        float fa[8];
#pragma unroll
        for (int h = 0; h < 8; ++h) fa[h] = 0.f;
        GAS unsigned long long* o8 = (GAS unsigned long long*)(XN + (size_t)m * D) + ln;
        if (ln == 0) RS0[m] = rs;
#pragma unroll
        for (int j = 0; j < 4; ++j) { o8[64 * j] = (unsigned long long)pk2(v[j].x, v[j].y) | ((unsigned long long)pk2(v[j].z, v[j].w) << 32);
            v[j] = v[j] * rs * gq[j];
#pragma unroll
            for (int i = 0; i < 4; ++i) { const int k = 4 * ln + 256 * j + i; const f32x4 w0 = *(const LAS f32x4*)(Wf + k * 8), w1 = *(const LAS f32x4*)(Wf + k * 8 + 4); const float hv = v[j][i];
                fa[0] += hv * w0.x; fa[1] += hv * w0.y; fa[2] += hv * w0.z; fa[3] += hv * w0.w; fa[4] += hv * w1.x; fa[5] += hv * w1.y; fa[6] += hv * w1.z; fa[7] += hv * w1.w; } }
#pragma unroll
        for (int h = 0; h < 8; ++h) fa[h] = wave_sum(fa[h]);
        if (ln < 8) { float f = fa[0];
#pragma unroll
            for (int h = 1; h < 8; ++h) f = (ln == h) ? fa[h] : f;
            f += bfg;
            const float lf = fminf(f, 0.f) - log1pf(expf(-fabsf(f)));
            const int b = m / SEQ, s_ = m % SEQ; LOGF[(size_t)(b * 8 + ln) * SEQ + s_] = lf; }
        s = 0.f;
#pragma unroll
        for (int j = 0; j < 4; ++j) { v[j] = nv[j]; s += (v[j].x * v[j].x + v[j].y * v[j].y) + (v[j].z * v[j].z + v[j].w * v[j].w); }
      } }
    __syncthreads();
}

constexpr int WPH = 1032;
__device__ __forceinline__ void stage_router(const float* w_router, const float* g_ffn, LAS unsigned short* Wh, int t, int nt) {
    LAS unsigned short* Wl = Wh + NE * WPH;
    for (int i0 = t; i0 < D * NE / 4; i0 += 6 * nt) { f32x4 wv[6];
#pragma unroll
        for (int u = 0; u < 6; ++u) { const int i = i0 + u * nt; if (i < D * NE / 4) wv[u] = ((const GAS f32x4*)w_router)[i]; }
#pragma unroll
        for (int u = 0; u < 6; ++u) { const int i = i0 + u * nt; if (i < D * NE / 4) { const int k = i >> 3, e0 = (i & 7) * 4; const f32x4 w = wv[u] * g_ffn[k];
#pragma unroll
            for (int j = 0; j < 4; ++j) { const unsigned h = f2bf(w[j]); const float lo = w[j] - __uint_as_float(h << 16); Wh[(e0 + j) * WPH + k] = (unsigned short)h; Wl[(e0 + j) * WPH + k] = (unsigned short)f2bf(lo); } } } }
}

__global__ void __launch_bounds__(NTHR, 2) fwd_kernel(Args args) {
    extern __shared__ __attribute__((aligned(16))) unsigned char lds[];
    Frame F;
    F.lds = (LAS unsigned char*)lds; F.tid = threadIdx.x; F.wave = __builtin_amdgcn_readfirstlane(F.tid >> 6); F.G = gridDim.x; F.bid = blockIdx.x;
    F.x = args.in[0]; F.g_attn = args.in[1]; F.w_in = args.in[2]; F.b_forget = args.in[3]; F.g_fox = args.in[4]; F.g_sb = args.in[5]; F.w_out = args.in[6]; F.g_ffn = args.in[7];
    F.w_router = args.in[8]; F.b_router = args.in[9]; F.w_gu = args.in[10]; F.b_gu = args.in[11]; F.w_d = args.in[12]; F.b_d = args.in[13]; F.g_final = args.in[14];
    F.out = args.out; F.ws = args.ws;
    volatile LAS unsigned* MISC = (volatile LAS unsigned*)(F.lds + MISC_OFF);
    for (int u = F.tid; u < (LDS_BYTES - 131072) / 4; u += NTHR) ((LAS unsigned*)(F.lds + 131072))[u] = 0u;
    __syncthreads();
    unsigned* ctl = (unsigned*)(F.ws + WS_CTL);
    XcdBarrier bar = xcd_barrier_post(ctl + CW_BAR, MISC + 8);
    if (threadIdx.x == 0 && (F.G % 8 != 0 || bar.x != (unsigned)(F.bid % 8))) atomicOr(ctl + CW_MAPBAD, 1u);
    const int lo = args.ph_lo, hi = args.ph_hi;
#define IN(k) (lo <= (k) && (k) < hi)
#define SEAM(k) do { if (IN(k) && IN((k) + 1)) xcd_barrier(bar); } while (0)
    LAS float* As = (LAS float*)F.lds;

    if (IN(0)) { p0_prologue(F); }
    SEAM(0);
    if (IN(1)) {
        for (int j = F.bid; j < 16; j += F.G) {
            const float* lf = (const float*)(F.ws + WS_LOGF) + (size_t)j * SEQ; float* cl = (float*)(F.ws + WS_CL) + (size_t)j * SEQ;
            LAS float* part = (LAS float*)F.lds;
            float v[16]; float s = 0.f;
#pragma unroll
            for (int i = 0; i < 16; ++i) { s += lf[F.tid * 16 + i]; v[i] = s; }
            __syncthreads(); part[F.tid] = s; __syncthreads();
            if (F.tid == 0) { float run = 0.f; for (int i = 0; i < NTHR; ++i) { const float tmp = part[i]; part[i] = run; run += tmp; } }
            __syncthreads();
            const float base = part[F.tid];
#pragma unroll
            for (int i = 0; i < 16; ++i) cl[F.tid * 16 + i] = (base + v[i]) * LOG2E;
            __syncthreads();
        }
        __syncthreads();
        { pg8::Gemm g{(const bf16*)(F.ws + WS_XN), (const bf16*)(F.ws + WS_WIN), M, 3 * D, D}; pg8::StaticOrder S; S.init(M, 3 * D, F.G, F.bid);
          pg8::EpiQKV E{(bf16*)(F.ws + WS_Q), (size_t)(WS_K - WS_Q) / 2, C2, ctl + CW_KN, (const float*)(F.ws + WS_RS0)};
          pg8::gemm_phase<pg8::EpiQKV, pg8::StaticOrder, true, true>(F.lds, g, S, E); }
    }
    SEAM(1);
    if (IN(2)) {
        const int v0 = (F.G % 8 == 0) ? (F.bid % 8) * (F.G / 8) + F.bid / 8 : F.bid;
        if (F.tid == 16) *(LAS unsigned*)(F.lds + MISC_OFF) = 0u;
        if (F.tid < 16) { ((LAS unsigned*)(F.lds + att::G_DONE))[F.tid] = 0u; ((LAS unsigned*)(F.lds + att::G_ARR))[F.tid] = 0u;
                          ((LAS unsigned*)(F.lds + att::G_BYTES + att::G_DONE))[F.tid] = 0u; ((LAS unsigned*)(F.lds + att::G_BYTES + att::G_ARR))[F.tid] = 0u; }
        __syncthreads();
        const bf16* QO = (const bf16*)(F.ws + WS_Q); bf16* OB = (bf16*)(F.ws + WS_O); const bf16* KB = (const bf16*)(F.ws + WS_K); const bf16* VB = (const bf16*)(F.ws + WS_V); float* SSQ = (float*)(F.ws + WS_SSQ);
        bf16* Wgu_t = (bf16*)(F.ws + WS_WGU); bf16* Wd_t = (bf16*)(F.ws + WS_WD);
        constexpr int I_GU = 8 * 64, I_D = 8 * 32;
        unsigned epoch = 0u;
        if (F.wave < 4) { __builtin_amdgcn_s_setprio(3);
            for (int v = v0; v < 256; v += F.G) {
                const int bh = v >> 4, s_ = v & 15, b = bh >> 3, h = bh & 7;
                const float KN = sqrtf(__uint_as_float(ctl[CW_KN + (b * 16 + h) * 2]) + __uint_as_float(ctl[CW_KN + (b * 16 + h) * 2 + 1])) * 1.02f;
                const float* CLrow = (const float*)(F.ws + WS_CL) + (size_t)(b * 8 + h) * SEQ;
#pragma unroll 1
                for (int u = 0; u < 4; ++u) { const int qb = (u == 0) ? 63 - s_ : (u == 1) ? 47 - s_ : (u == 2) ? 16 + s_ : s_;
                    att::attn_unit4<true, ATT_PRUNE != 0>(b, h, qb, QO, OB, KB, VB, SSQ, CLrow, KN, (char*)lds, epoch);
                }
            }
            __builtin_amdgcn_s_setprio(0);
        } else { __builtin_amdgcn_s_setprio(3);
            for (int v = v0; v < 256; v += F.G) {
                const int bh = v >> 4, s_ = v & 15, b = bh >> 3, h = bh & 7;
#pragma unroll 1
                for (int u = 0; u < 4; ++u) { const int qb = (u == 0) ? 63 - s_ : (u == 1) ? 47 - s_ : (u == 2) ? 16 + s_ : s_;
                    att::attn_unit4<false, ATT_PRUNE != 0>(b, 8 + h, qb, QO, OB, KB, VB, SSQ, nullptr, 0.f, (char*)lds + att::G_BYTES, epoch); }
            }
            __builtin_amdgcn_s_setprio(0);
        }
        { const int gsel = F.wave >> 2;
          asm volatile("s_waitcnt vmcnt(0) lgkmcnt(0)" ::: "memory");
          att::grp_barrier((att::lds_vu32)(F.lds + gsel * att::G_BYTES + att::G_ARR), epoch, F.wave & 3, hw_lane());
          LAS unsigned* scr = (LAS unsigned*)(F.lds + gsel * att::G_BYTES + (F.wave & 3) * 4608);
          for (;;) {
              int n = 0; if (hw_lane() == 0) n = (int)__hip_atomic_fetch_add((LAS unsigned*)(F.lds + MISC_OFF), 2u, __ATOMIC_RELAXED, __HIP_MEMORY_SCOPE_WORKGROUP);
              n = __builtin_amdgcn_readfirstlane(n);
              int r = v0 * 4 + (n & 3) + (n >> 2) * 4 * F.G;
              if (r >= NE * (I_GU + I_D)) break;
              if (r < NE * I_GU) { const int e = r / I_GU; r -= e * I_GU; transpose_pair_fp8(F.w_gu + (size_t)e * D * 2 * DFF, 2 * DFF, D, (unsigned char*)Wgu_t + (size_t)e * 2 * DFF * D, r, 64, scr, hw_lane(), W8_SCALE); }
              else { r -= NE * I_GU; const int e = r / I_D; r -= e * I_D; transpose_pair_fp8(F.w_d + (size_t)e * DFF * D, D, DFF, (unsigned char*)Wd_t + (size_t)e * D * DFF, r, 32, scr, hw_lane(), W8_SCALE); }
          } }
        __syncthreads();
    }
    SEAM(2);
    if (IN(4)) {
        pg8::Gemm g{(const bf16*)(F.ws + WS_O), (const bf16*)(F.ws + WS_WOUT), M, D, D}; pg8::StaticOrder S; S.init(M, D, F.G, F.bid);
        pg8::EpiResMid E{(const unsigned short*)(F.ws + WS_XN), (unsigned short*)(F.ws + WS_X1), D, (const float*)(F.ws + WS_SSQ), (LAS float*)(F.lds + 131072)};
        pg8::gemm_phase<pg8::EpiResMid, pg8::StaticOrder, true, true>(F.lds, g, S, E);
    }
    if (IN(4) && IN(5)) xcd_barrier_work(bar, [&]() { stage_router(F.w_router, F.g_ffn, (LAS unsigned short*)F.lds, (int)threadIdx.x - 64, NTHR - 64); });
    if (IN(5)) {
        unsigned char* H8 = (unsigned char*)(F.ws + WS_XN); int* TOPE = (int*)(F.ws + WS_TOPE); float* GATE = (float*)(F.ws + WS_GATE); int* CNT = (int*)(F.ws + WS_CNT); const unsigned short* X1 = (const unsigned short*)(F.ws + WS_X1);
        LAS unsigned short* Wh = (LAS unsigned short*)F.lds;
        LAS float* Lg = (LAS float*)(F.lds + 2 * NE * WPH * 2);
        LAS float* RS = Lg + 64 * 32;
        LAS int* hist = (LAS int*)(RS + 64);
        __syncthreads();
        if (!IN(4)) stage_router(F.w_router, F.g_ffn, Wh, F.tid, NTHR);
        const int ln = hw_lane(), mt = F.wave >> 1, kh = F.wave & 1, r16 = ln & 15, kq = ln >> 4;
        const float brt0 = F.b_router[r16], brt1 = F.b_router[16 + r16];
        LAS float* Pp = Lg;
        f32x4 gq5[4];
#pragma unroll
        for (int j = 0; j < 4; ++j) gq5[j] = *((const GAS f32x4*)F.g_ffn + ln + 64 * j);
        for (int vb = F.bid; vb < NVB; vb += F.G) {
            __syncthreads(); if (F.tid < NE) hist[F.tid] = 0;
            { typedef short s16x8 __attribute__((ext_vector_type(8)));
              const GAS s16x8* xrow = (const GAS s16x8*)(X1 + (size_t)(vb * VBT + mt * 16 + r16) * D + 512 * kh + 8 * kq); const LAS s16x8* wrow = (const LAS s16x8*)(Wh + r16 * WPH + 512 * kh + 8 * kq);
              f32x4 acc0 = {0.f, 0.f, 0.f, 0.f}, acc1 = {0.f, 0.f, 0.f, 0.f}; float ssq = 0.f;
              s16x8 ax[16];
#pragma unroll
              for (int i = 0; i < 16; ++i) ax[i] = xrow[4 * i];
#pragma unroll
              for (int i = 0; i < 16; ++i) { const s16x8 a = ax[i];
                  const s16x8 bh0 = wrow[4 * i], bh1 = wrow[4 * i + 16 * WPH / 8], bl0 = wrow[4 * i + NE * WPH / 8], bl1 = wrow[4 * i + (NE + 16) * WPH / 8];
#pragma unroll
                  for (int t = 0; t < 8; ++t) { const float xf = __uint_as_float((unsigned)(unsigned short)a[t] << 16); ssq += xf * xf; }
                  acc0 = __builtin_amdgcn_mfma_f32_16x16x32_bf16(a, bl0, acc0, 0, 0, 0); acc1 = __builtin_amdgcn_mfma_f32_16x16x32_bf16(a, bl1, acc1, 0, 0, 0);
                  acc0 = __builtin_amdgcn_mfma_f32_16x16x32_bf16(a, bh0, acc0, 0, 0, 0); acc1 = __builtin_amdgcn_mfma_f32_16x16x32_bf16(a, bh1, acc1, 0, 0, 0); }
              ssq += __shfl_xor(ssq, 16); ssq += __shfl_xor(ssq, 32);
              if (kh == 1) { *(LAS f32x4*)(Pp + ((mt * 2 + 0) * 64 + ln) * 4) = acc0; *(LAS f32x4*)(Pp + ((mt * 2 + 1) * 64 + ln) * 4) = acc1; if (kq == 0) RS[mt * 16 + r16] = ssq; }
              __syncthreads();
              if (kh == 0) { const f32x4 q0 = *(const LAS f32x4*)(Pp + ((mt * 2 + 0) * 64 + ln) * 4), q1 = *(const LAS f32x4*)(Pp + ((mt * 2 + 1) * 64 + ln) * 4);
                  acc0 = acc0 + q0; acc1 = acc1 + q1; ssq += RS[mt * 16 + r16];
                  const float rsr = 1.0f / sqrtf(ssq * (1.f / D) + EPS);
                  if (kq == 0) RS[mt * 16 + r16] = rsr;
#pragma unroll
                  for (int j = 0; j < 4; ++j) { const int row = 4 * kq + j; const float rsj = __shfl(rsr, row);
                      Lg[(mt * 16 + row) * 32 + r16] = acc0[j] * rsj + brt0; Lg[(mt * 16 + row) * 32 + 16 + r16] = acc1[j] * rsj + brt1; } } }
            __syncthreads();
            for (int rr = 0; rr < VBT / NWAVES; ++rr) {
                const int row = F.wave * (VBT / NWAVES) + rr, m = vb * VBT + row;
                const GAS v2u_b* xr = (const GAS v2u_b*)(X1 + (size_t)m * D) + ln;
                f32x4 v[4];
#pragma unroll
                for (int j = 0; j < 4; ++j) v[j] = bf4(xr[64 * j]);
                const float vv = Lg[row * 32 + (ln & 31)]; const int myi = ln & 31; int rank = 0;
#pragma unroll
                for (int e = 0; e < NE; ++e) { const float se = __builtin_bit_cast(float, __builtin_amdgcn_readlane(__builtin_bit_cast(int, vv), e)); rank += (se > vv || (se == vv && e < myi)) ? 1 : 0; }
                float sv[TOPK]; int si[TOPK];
#pragma unroll
                for (int r = 0; r < TOPK; ++r) { const unsigned long long mk = __ballot(rank == r && ln < 32); const int li = __builtin_amdgcn_readfirstlane((int)__builtin_ctzll(mk));
                    si[r] = li; sv[r] = __builtin_bit_cast(float, __builtin_amdgcn_readlane(__builtin_bit_cast(int, vv), li)); }
                if (ln == 0) { const float x1_ = expf(sv[1] - sv[0]), x2_ = expf(sv[2] - sv[0]), x3_ = expf(sv[3] - sv[0]); const float inv = 1.f / (1.f + x1_ + x2_ + x3_);
                    *(GAS f32x4*)(GATE + (size_t)m * 4) = (f32x4){inv, x1_ * inv, x2_ * inv, x3_ * inv};
                    TOPE[(size_t)m * 4 + 0] = si[0]; TOPE[(size_t)m * 4 + 1] = si[1]; TOPE[(size_t)m * 4 + 2] = si[2]; TOPE[(size_t)m * 4 + 3] = si[3];
                    atomicAdd((int*)&hist[si[0]], 1); atomicAdd((int*)&hist[si[1]], 1); atomicAdd((int*)&hist[si[2]], 1); atomicAdd((int*)&hist[si[3]], 1); }
                const float rs = RS[row] * X8_SCALE;
                GAS unsigned* o4 = (GAS unsigned*)(H8 + (size_t)m * D) + ln;
#pragma unroll
                for (int j = 0; j < 4; ++j) { const f32x4 h = v[j] * rs * gq5[j]; o4[64 * j] = pg8::cvt4_fp8(h.x, h.y, h.z, h.w); }
            }
            __syncthreads();
            if (F.tid < NE) CNT[vb * NE + F.tid] = hist[F.tid];
        }
        __syncthreads();
    }
    SEAM(5);
    if (IN(6)) {
        const int* TOPE = (const int*)(F.ws + WS_TOPE); const float* GATE = (const float*)(F.ws + WS_GATE); const int* CNT = (const int*)(F.ws + WS_CNT);
        int* ROWTOK = (int*)(F.ws + WS_ROWTOK); int* ROWDST = (int*)(F.ws + WS_ROWDST); float* GSLOT = (float*)(F.ws + WS_GSLOT2); int* TILE = (int*)(F.ws + WS_TILE);
        LAS int* es = (LAS int*)F.lds; LAS int* tot = es + 256; LAS int* bef = tot + 32; LAS int* ps = bef + 32; LAS int* part = ps + 32;
        for (int vb = F.bid; vb < NVB; vb += F.G) {
            __syncthreads();
            float gate_ = 0.f;
            if (F.tid < 256) { es[F.tid] = TOPE[(size_t)vb * VBT * 4 + F.tid]; gate_ = GATE[(size_t)vb * VBT * 4 + F.tid]; }
            { const int e = F.tid & 31, qg = F.tid >> 5; int cv[16];
#pragma unroll
              for (int i = 0; i < 16; ++i) cv[i] = CNT[(qg * 16 + i) * NE + e];
              int t_ = 0, b_ = 0;
#pragma unroll
              for (int i = 0; i < 16; ++i) { t_ += cv[i]; b_ += (qg * 16 + i < vb) ? cv[i] : 0; }
              part[qg * 32 + e] = t_; part[512 + qg * 32 + e] = b_; }
            __syncthreads();
            if (F.tid < NE) { int t_ = 0, b_ = 0;
#pragma unroll
                for (int qg = 0; qg < 16; ++qg) { t_ += part[qg * 32 + F.tid]; b_ += part[512 + qg * 32 + F.tid]; }
                tot[F.tid] = t_; bef[F.tid] = b_; }
            __syncthreads();
            if (F.tid < NE) { int nt = 0;
                for (int e = 0; e < F.tid; ++e) nt += (tot[e] + 255) / 256;
                ps[F.tid] = nt * 256;
                if (vb == NE) { const int k = (tot[F.tid] + 255) / 256; for (int i = 0; i < k; ++i) TILE[16 + nt + i] = F.tid; if (F.tid == NE - 1) TILE[0] = nt + k; } }
            __syncthreads();
            if (F.tid < 256) { const int e = es[F.tid]; int rank = 0;
#pragma unroll 8
                for (int j4 = 0; j4 < 64; ++j4) { const v4u q = *(const LAS v4u*)(es + 4 * j4); const int j = 4 * j4;
                    rank += ((int)q.x == e && j < F.tid) + ((int)q.y == e && j + 1 < F.tid) + ((int)q.z == e && j + 2 < F.tid) + ((int)q.w == e && j + 3 < F.tid); }
                const int slot = ps[e] + bef[e] + rank; const int a = vb * VBT * 4 + F.tid; ROWTOK[slot] = a >> 2; ROWDST[slot] = a; GSLOT[slot] = gate_;  }
            if (vb < NE) {
                const int n0 = ps[vb] + tot[vb], n1 = ps[vb] + (tot[vb] + 255) / 256 * 256;
                for (int r = n0 + F.tid; r < n1; r += NTHR) { ROWTOK[r] = 0; ROWDST[r] = -1; GSLOT[r] = 0.f; } }
        }
    }
    SEAM(6);
    if (IN(7)) {
        pg8::Gemm g{(const bf16*)(F.ws + WS_XN), (const bf16*)(F.ws + WS_WGU), MAXROWS, 2 * DFF, D / 2}; pg8::GroupedOrderT<1> S; S.init((const int*)(F.ws + WS_TILE), 8, F.G, F.bid, ctl + CW_TC, 0u, 0);
        pg8::EpiSwiglu E{(unsigned char*)(F.ws + WS_ACT), F.b_gu, 1.f / (X8_SCALE * W8_SCALE), A8_SCALE};
        pg8::gemm_phase<pg8::EpiSwiglu, pg8::GroupedOrderT<1>, true, true, true, true>(F.lds, g, S, E, (const int*)(F.ws + WS_ROWTOK));
    }
    if (IN(7) && IN(8)) { if (__builtin_amdgcn_readfirstlane((int)__hip_atomic_load(ctl + CW_MAPBAD, __ATOMIC_RELAXED, __HIP_MEMORY_SCOPE_AGENT)) != 0) xcd_barrier(bar); }
    if (IN(8)) {
        pg8::Gemm g{(const bf16*)(F.ws + WS_ACT), (const bf16*)(F.ws + WS_WD), MAXROWS, D, DFF / 2}; pg8::GroupedOrderT<2> S; S.init((const int*)(F.ws + WS_TILE), 4, F.G, F.bid, ctl + CW_TC, 8u * NWAVES, 8);
        pg8::EpiDownG E{(unsigned char*)(F.ws + WS_XS), F.b_d, (const float*)(F.ws + WS_GSLOT2), (const int*)(F.ws + WS_ROWDST), 1.f / (A8_SCALE * W8_SCALE), Y8_SCALE};
        pg8::gemm_phase<pg8::EpiDownG, pg8::GroupedOrderT<2>, true, true, false, true>(F.lds, g, S, E);
    }
    SEAM(8);
    if (IN(9)) {
        const bf16* Y = (const bf16*)(F.ws + WS_XS);
        const int gw = F.bid * NWAVES + F.wave, NGW = F.G * NWAVES;
        f32x4 gq9[4];
#pragma unroll
        for (int j = 0; j < 4; ++j) gq9[j] = *((const GAS f32x4*)F.g_final + hw_lane() + 64 * j);
        for (int m = gw; m < M; m += NGW) {
            GAS f32x4* xr = (GAS f32x4*)(F.out + (size_t)m * D) + hw_lane(); const GAS v2u_b* x1r = (const GAS v2u_b*)((const unsigned short*)(F.ws + WS_X1) + (size_t)m * D) + hw_lane();
            f32x4 v[4];
#pragma unroll
            for (int j = 0; j < 4; ++j) v[j] = bf4(x1r[64 * j]);
#pragma unroll
            for (int k = 0; k < TOPK; ++k) { const GAS unsigned* yr = (const GAS unsigned*)((const unsigned char*)Y + ((size_t)m * 4 + k) * D) + hw_lane();
#pragma unroll
                for (int j = 0; j < 4; ++j) { const unsigned w = yr[64 * j]; typedef float f2_ __attribute__((ext_vector_type(2))); const f2_ lo = __builtin_amdgcn_cvt_pk_f32_fp8((int)w, false), hi = __builtin_amdgcn_cvt_pk_f32_fp8((int)w, true);
                    v[j].x += lo.x * (1.f / Y8_SCALE); v[j].y += lo.y * (1.f / Y8_SCALE); v[j].z += hi.x * (1.f / Y8_SCALE); v[j].w += hi.y * (1.f / Y8_SCALE); } }
            float s = 0.f;
#pragma unroll
            for (int j = 0; j < 4; ++j) s += (v[j].x * v[j].x + v[j].y * v[j].y) + (v[j].z * v[j].z + v[j].w * v[j].w);
            const float rs = 1.0f / sqrtf(wave_sum(s) * (1.f / D) + EPS);
#pragma unroll
            for (int j = 0; j < 4; ++j) xr[64 * j] = v[j] * rs * gq9[j];
        }
    }
#undef IN
#undef SEAM
}

extern "C" void kernel_launch(void* const* d_in, const int* in_sizes, int n_in, void* d_out, int out_size, void* d_ws, size_t ws_size, hipStream_t stream) {
    static int grid = 0;
    if (grid == 0) {
        if (n_in != 15 || out_size != M * D || ws_size < WS_END) { fprintf(stderr, "kernel_launch: unexpected problem (n_in %d out %d ws %zu)\n", n_in, out_size, ws_size); grid = -1; return; }
        int dev = 0, cus = 0, per_cu = 0;
        if (hipGetDevice(&dev) != hipSuccess || hipDeviceGetAttribute(&cus, hipDeviceAttributeMultiprocessorCount, dev) != hipSuccess) { grid = -1; return; }
        if (hipFuncSetAttribute((const void*)fwd_kernel, hipFuncAttributeMaxDynamicSharedMemorySize, LDS_BYTES) != hipSuccess) { fprintf(stderr, "kernel_launch: hipFuncSetAttribute failed\n"); grid = -1; return; }
        if (hipOccupancyMaxActiveBlocksPerMultiprocessor(&per_cu, (const void*)fwd_kernel, NTHR, LDS_BYTES) != hipSuccess || per_cu < 1) { fprintf(stderr, "kernel_launch: occupancy query says %d blocks/CU\n", per_cu); (void)hipGetLastError(); grid = -1; return; }
        grid = cus;
    }
    if (grid < 0) return;
    if (hipMemsetAsync((char*)d_ws + WS_CTL, 0, CTL_ZERO_BYTES, stream) != hipSuccess) return;
    Args a{};
    for (int i = 0; i < 15; ++i) a.in[i] = (const float*)d_in[i];
    a.out = (float*)d_out; a.ws = (unsigned char*)d_ws; a.ph_lo = 0; a.ph_hi = 10;
    hipLaunchKernelGGL(fwd_kernel, dim3(grid), dim3(NTHR), LDS_BYTES, stream, a);
}
```

```cpp
#include <hip/hip_runtime.h>
#include <cstdio>
#include <cstdint>

#define GAS __attribute__((address_space(1)))
#define LAS __attribute__((address_space(3)))
typedef unsigned short bf16;
typedef float f32x4 __attribute__((ext_vector_type(4)));
typedef unsigned v4u __attribute__((ext_vector_type(4)));
typedef unsigned v2u __attribute__((ext_vector_type(2)));
typedef GAS unsigned gu32;
#define RLX_AGENT __ATOMIC_RELAXED, __HIP_MEMORY_SCOPE_AGENT
#define LDS_WAIT() asm volatile("s_waitcnt lgkmcnt(0)" ::: "memory")
#define VM_WAIT() asm volatile("s_waitcnt vmcnt(0)" ::: "memory")

constexpr int BATCH = 2, SEQ = 8192, D = 1024, M = BATCH * SEQ, NH = 16  , HD = 64;
constexpr int INC = 3080, NE = 32, TOPK = 4, DFF = 1024;
constexpr float EPS = 1e-5f, LOG2E = 1.4426950408889634f, C2 = 0.125f * 1.4426950408889634f;
constexpr int MAXTILES = 288, MAXROWS = MAXTILES * 256;
constexpr int NWAVES = 8, NTHR = 512;
constexpr float W8_SCALE = 64.f, X8_SCALE = 16.f, A8_SCALE = 8.f, Y8_SCALE = 32.f;
constexpr int NVB = 256, VBT = M / NVB;

constexpr size_t MiB = 1u << 20;
constexpr size_t WS_CTL = 0, CTL_ZERO_BYTES = 64 * 1024;
constexpr size_t WS_WIN = 2 * MiB, WS_WOUT = 8 * MiB, WS_WGU = 16 * MiB, WS_WD = 144 * MiB;
constexpr size_t WS_XN = 208 * MiB;
constexpr size_t WS_SSQ = 240 * MiB;
constexpr size_t WS_LOGF = 241 * MiB, WS_CL = WS_LOGF + 512 * 1024;
constexpr size_t WS_TOPE = 242 * MiB, WS_GATE = WS_TOPE + 256 * 1024, WS_SLOT = WS_GATE + 256 * 1024, WS_GSLOT = WS_SLOT + 256 * 1024;
constexpr size_t WS_CNT = 243 * MiB + 256 * 1024, WS_TILE = 243 * MiB + 512 * 1024;
constexpr size_t WS_ROWTOK = 244 * MiB, WS_ROWDST = WS_ROWTOK + 512 * 1024, WS_GSLOT2 = WS_ROWDST + 512 * 1024;
constexpr size_t WS_Q = 256 * MiB, WS_K = 288 * MiB, WS_V = 320 * MiB;
constexpr size_t WS_O = 352 * MiB;
constexpr size_t WS_XS = 256 * MiB;
constexpr size_t WS_ACT = 400 * MiB;
constexpr size_t WS_XS8 = 480 * MiB;
constexpr size_t WS_RS0 = 246 * MiB;
constexpr size_t WS_X1 = 560 * MiB;
constexpr size_t WS_END = 624 * MiB;
constexpr int CW_TC = 0, CW_MAPBAD = 3072, CW_BAR = 4096, CW_KN = 8192;
#ifndef ATT_PRUNE
#define ATT_PRUNE 1
#endif

constexpr int LDS_BYTES = 147456;
constexpr int MISC_OFF = LDS_BYTES - 128;

__device__ __forceinline__ unsigned f2bf(float f) { unsigned u = __builtin_bit_cast(unsigned, f); return (u + 0x7fffu + ((u >> 16) & 1u)) >> 16; }
__device__ __forceinline__ unsigned pk2(float lo, float hi) { return f2bf(lo) | (f2bf(hi) << 16); }
typedef unsigned v2u_b __attribute__((ext_vector_type(2)));
__device__ __forceinline__ f32x4 bf4(v2u_b w) { return (f32x4){__uint_as_float(w.x << 16), __uint_as_float(w.x & 0xffff0000u), __uint_as_float(w.y << 16), __uint_as_float(w.y & 0xffff0000u)}; }
__device__ __forceinline__ float bflo(unsigned w) { return __builtin_bit_cast(float, w << 16); }
__device__ __forceinline__ float bfhi(unsigned w) { return __builtin_bit_cast(float, w & 0xffff0000u); }
__device__ __forceinline__ float wave_sum(float v) {
#pragma unroll
    for (int o = 1; o < 64; o <<= 1) v += __shfl_xor(v, o);
    return v;
}

namespace pg8 {
#define PG8_LAS __attribute__((address_space(3)))
typedef unsigned short bf16_t;
typedef short bf16x8 __attribute__((ext_vector_type(8)));
typedef float f32x4 __attribute__((ext_vector_type(4)));
typedef unsigned u32x4 __attribute__((ext_vector_type(4)));
typedef unsigned u32x2 __attribute__((ext_vector_type(2)));
typedef int i32x4_t __attribute__((ext_vector_type(4)));
constexpr int BM = 256, BK = 64, HALF = 128, HTB = HALF * BK * 2  , STAGE_BYTES = 8 * HTB, NXCD = 8, WGM = 8;

__host__ __device__ __forceinline__ int lds_byte(int r, int c) { const int st = (r >> 4) * 2 + (c >> 5), rr = r & 15, cc = c & 31, ob = rr * 64 + cc * 2; return st * 1024 + (ob ^ (((ob >> 9) & 1) << 5)); }
__host__ __device__ __forceinline__ void stage_rc(int b, int& R, int& C) { const int st = b / 1024, sb = b % 1024, swz = sb ^ (((sb >> 9) & 1) << 5); R = (st >> 1) * 16 + swz / 64; C = (st & 1) * 32 + (swz % 64) / 2; }
__host__ __device__ __forceinline__ int perm32(int rho) { const int n = rho >> 4, i = rho & 15; return 8 * (i >> 2) + 4 * n + (i & 3); }

struct Unit { int pm, pn; };
struct Gemm { const bf16_t* A; const bf16_t* Bt; int M, N, K; };

struct StaticOrder {
    int nM, nN, nwg, G, c;
    __host__ __device__ void init(int M, int N, int G_, int c_) { nM = M / BM; nN = N / BM; nwg = nM * nN; G = G_; c = c_; }
    __host__ __device__ bool next(int i, Unit& u) const {
        const long L = (long)i * G + c; if (L >= nwg) return false;
        int wgid = (int)L; { const int q = nwg / NXCD, r = nwg % NXCD, xcd = wgid % NXCD, off = wgid / NXCD; wgid = (xcd < r ? xcd * (q + 1) : r * (q + 1) + (xcd - r) * q) + off; }
        const int nig = WGM * nN, gid = wgid / nig, fm = gid * WGM, gsz = (nM - fm) < WGM ? (nM - fm) : WGM;
        u.pm = fm + ((wgid % nig) % gsz); u.pn = (wgid % nig) / gsz; return true;
    }
    static constexpr int MODE = 0;
    __device__ __forceinline__ void a_ready(const Unit&) const {}
    __device__ __forceinline__ void done(const Unit&) const {}
    __device__ __forceinline__ unsigned flag_load(const Unit&) const { return 0u; }
    __device__ __forceinline__ void a_ready_pref(const Unit&, unsigned) const {}
    __device__ __forceinline__ void publish(int) const {}
};
__device__ __forceinline__ unsigned cvt_pk_bf16(float lo, float hi) { unsigned r; asm volatile("v_cvt_pk_bf16_f32 %0, %1, %2" : "=v"(r) : "v"(lo), "v"(hi)); return r; }
typedef float f32x2 __attribute__((ext_vector_type(2)));
__device__ __forceinline__ f32x2 gelu_pk(f32x2 v) {
    const f32x2 av = __builtin_elementwise_abs(v), d = av * 0.2316418882f + 1.0f;
    f32x2 t; t.x = __builtin_amdgcn_rcpf(d.x); t.y = __builtin_amdgcn_rcpf(d.y);
    f32x2 q = t * 0.5307027145f + (-0.7265760135f); q = q * t + 0.7107068705f; q = q * t + (-0.142248368f); q = q * t + 0.127414796f; q = q * t;
    const f32x2 s = (v * v) * (-0.72134752044f);
    f32x2 e; e.x = __builtin_amdgcn_exp2f(s.x); e.y = __builtin_amdgcn_exp2f(s.y);
    const f32x2 m = v * (q * e), r = v - m;
    f32x2 o; o.x = v.x < 0.f ? m.x : r.x; o.y = v.y < 0.f ? m.y : r.y; return o;
}

template <int ACT  > struct EpiBf16 {
    static constexpr bool PERM = true, AFTER_DRAIN = false, MIDK = false; static_assert(ACT == 0 || ACT == 1, "EpiBf16: ACT is 0 (none) or 1 (gelu_pk)");
    bf16_t* O; int ldc; const float* bias; int split_cols; size_t split_stride; float scale0;
    __device__ __forceinline__ void operator()(const f32x4 (&acc)[2][2][4][2], const Unit& u, int wr, int wc, int fr, int fq) const {
        const int row0 = u.pm * BM + wr * 64 + fr; int colt = u.pn * BM; bf16_t* base = O;
        float sc = 1.f; if (split_cols) { const int t = colt / split_cols; base += (size_t)t * split_stride; colt -= t * split_cols; if (t == 0) sc = scale0; }
        const int col0 = colt + wc * 32 + 8 * fq, bcol0 = u.pn * BM + wc * 32 + 8 * fq;
        f32x4 bv[2][2];
#pragma unroll
        for (int bj = 0; bj < 2; ++bj)
#pragma unroll
            for (int n = 0; n < 2; ++n) bv[bj][n] = bias ? *(const f32x4*)(bias + bcol0 + bj * HALF + 4 * n) : (f32x4){0.f, 0.f, 0.f, 0.f};
#pragma unroll
        for (int ai = 0; ai < 2; ++ai)
#pragma unroll
            for (int m = 0; m < 4; ++m) { bf16_t* rowp = base + (size_t)(row0 + ai * HALF + m * 16) * ldc + col0;
#pragma unroll
                for (int bj = 0; bj < 2; ++bj) { f32x4 v0 = acc[ai][bj][m][0] + bv[bj][0], v1 = acc[ai][bj][m][1] + bv[bj][1];
                    if (ACT == 1) { f32x2 a = gelu_pk((f32x2){v0[0], v0[1]}), b = gelu_pk((f32x2){v0[2], v0[3]}), c = gelu_pk((f32x2){v1[0], v1[1]}), d = gelu_pk((f32x2){v1[2], v1[3]});
                        v0 = (f32x4){a.x, a.y, b.x, b.y}; v1 = (f32x4){c.x, c.y, d.x, d.y}; }
                    v0 = v0 * sc; v1 = v1 * sc; u32x4 w; w.x = cvt_pk_bf16(v0[0], v0[1]); w.y = cvt_pk_bf16(v0[2], v0[3]); w.z = cvt_pk_bf16(v1[0], v1[1]); w.w = cvt_pk_bf16(v1[2], v1[3]);
                    *(u32x4*)(rowp + bj * HALF) = w; } }
    }
};

struct EpiResF32 { static constexpr bool PERM = false, AFTER_DRAIN = false, MIDK = false; const float* base; float* out; int ldc;
    __device__ __forceinline__ void operator()(const f32x4 (&acc)[2][2][4][2], const Unit& u, int wr, int wc, int fr, int fq) const {
        const int col0 = u.pn * BM + wc * 32 + 4 * fq;
#pragma unroll
        for (int ai = 0; ai < 2; ++ai)
#pragma unroll
            for (int m = 0; m < 4; ++m) { const size_t off = (size_t)(u.pm * BM + ai * HALF + wr * 64 + m * 16 + fr) * ldc + col0;
#pragma unroll
                for (int bj = 0; bj < 2; ++bj)
#pragma unroll
                    for (int n = 0; n < 2; ++n) { const f32x4 b = *(const f32x4*)(base + off + bj * HALF + n * 16); *(f32x4*)(out + off + bj * HALF + n * 16) = b + acc[ai][bj][m][n]; } }
    } };

struct EpiResMid { static constexpr bool PERM = false, AFTER_DRAIN = false, MIDK = true; const unsigned short* base; unsigned short* out; int ldc; const float* ssq; PG8_LAS float* tab;
    __device__ __forceinline__ void prep(const Unit& u, int par, int tid) const {
        if (tid < 256) { const f32x4* sp = (const f32x4*)(ssq + (size_t)(u.pm * BM + tid) * 16); const f32x4 s0 = sp[0], s1 = sp[1], s2 = sp[2], s3 = sp[3];
            const float sa = (s0[0] + s0[1]) + (s0[2] + s0[3]) + (s1[0] + s1[1]) + (s1[2] + s1[3]), sb = (s2[0] + s2[1]) + (s2[2] + s2[3]) + (s3[0] + s3[1]) + (s3[2] + s3[3]);
            const float rsa = 1.0f / sqrtf(sa * (1.f / 512.f) + 1e-5f), rsb = 1.0f / sqrtf(sb * (1.f / 512.f) + 1e-5f);
            tab[(par * 256 + tid) * 2] = rsa / rsb; tab[(par * 256 + tid) * 2 + 1] = rsb; } }
    __device__ __forceinline__ void prep_load(const Unit& u, int tid, f32x4 (&s)[4]) const {
        if (tid < 256) { const f32x4* sp = (const f32x4*)(ssq + (size_t)(u.pm * BM + tid) * 16); s[0] = sp[0]; s[1] = sp[1]; s[2] = sp[2]; s[3] = sp[3]; } }
    __device__ __forceinline__ void prep_fin(int par, int tid, const f32x4 (&s)[4]) const {
        if (tid < 256) { const f32x4 s0 = s[0], s1 = s[1], s2 = s[2], s3 = s[3];
            const float sa = (s0[0] + s0[1]) + (s0[2] + s0[3]) + (s1[0] + s1[1]) + (s1[2] + s1[3]), sb = (s2[0] + s2[1]) + (s2[2] + s2[3]) + (s3[0] + s3[1]) + (s3[2] + s3[3]);
            const float rsa = 1.0f / sqrtf(sa * (1.f / 512.f) + 1e-5f), rsb = 1.0f / sqrtf(sb * (1.f / 512.f) + 1e-5f);
            tab[(par * 256 + tid) * 2] = rsa / rsb; tab[(par * 256 + tid) * 2 + 1] = rsb; } }
    __device__ __forceinline__ void midk(f32x4 (&acc)[2][2][4][2], int par, int wr, int fr) const {
#pragma unroll
        for (int ai = 0; ai < 2; ++ai)
#pragma unroll
            for (int m = 0; m < 4; ++m) { const float f = tab[(par * 256 + ai * HALF + wr * 64 + m * 16 + fr) * 2];
#pragma unroll
                for (int bj = 0; bj < 2; ++bj)
#pragma unroll
                    for (int n = 0; n < 2; ++n) acc[ai][bj][m][n] *= f; } }
    __device__ __forceinline__ void epi(const f32x4 (&acc)[2][2][4][2], const Unit& u, int par, int wr, int wc, int fr, int fq) const {
        const int col0 = u.pn * BM + wc * 32 + 4 * fq;
        u32x2 rb[2][4][2][2];
#pragma unroll
        for (int ai = 0; ai < 2; ++ai)
#pragma unroll
            for (int m = 0; m < 4; ++m) { const int r = ai * HALF + wr * 64 + m * 16 + fr; const size_t off = (size_t)(u.pm * BM + r) * ldc + col0;
#pragma unroll
                for (int bj = 0; bj < 2; ++bj)
#pragma unroll
                    for (int n = 0; n < 2; ++n) rb[ai][m][bj][n] = *(const u32x2*)(base + off + bj * HALF + n * 16); }
#pragma unroll
        for (int ai = 0; ai < 2; ++ai)
#pragma unroll
            for (int m = 0; m < 4; ++m) { const int r = ai * HALF + wr * 64 + m * 16 + fr; const float f = tab[(par * 256 + r) * 2 + 1]; const size_t off = (size_t)(u.pm * BM + r) * ldc + col0;
#pragma unroll
                for (int bj = 0; bj < 2; ++bj)
#pragma unroll
                    for (int n = 0; n < 2; ++n) { const f32x4 b = bf4(rb[ai][m][bj][n]); const f32x4 v = b + acc[ai][bj][m][n] * f;
                        u32x2 w; w.x = cvt_pk_bf16(v[0], v[1]); w.y = cvt_pk_bf16(v[2], v[3]); *(u32x2*)(out + off + bj * HALF + n * 16) = w; } } }
    __device__ __forceinline__ void operator()(const f32x4 (&)[2][2][4][2], const Unit&, int, int, int, int) const {}
};
__device__ __forceinline__ float sgpr_f(unsigned bits) { return __builtin_bit_cast(float, __builtin_amdgcn_readfirstlane((int)bits)); }
__device__ __forceinline__ float swiglu1(float g, float u) { const float c7 = sgpr_f(0x40e00000u); g = fminf(g, c7); u = fminf(fmaxf(u, -c7), c7); const float s = __builtin_amdgcn_rcpf(1.f + __builtin_amdgcn_exp2f(g * (-1.702f * 1.4426950408889634f))); return g * s * (u + 1.f); }
__device__ __forceinline__ unsigned cvt4_fp8(float a, float b, float c, float d) {
    const float mx = __builtin_bit_cast(float, __builtin_amdgcn_readfirstlane(0x43e00000)); a = fminf(fmaxf(a, -mx), mx); b = fminf(fmaxf(b, -mx), mx); c = fminf(fmaxf(c, -mx), mx); d = fminf(fmaxf(d, -mx), mx);
    int w = 0; w = __builtin_amdgcn_cvt_pk_fp8_f32(a, b, w, false); w = __builtin_amdgcn_cvt_pk_fp8_f32(c, d, w, true); return (unsigned)w; }
struct EpiSwiglu { static constexpr bool PERM = true, AFTER_DRAIN = false, MIDK = false; unsigned char* ACT; const float* bias; float sc_in, sc_out;
    __device__ __forceinline__ void operator()(const f32x4 (&acc)[2][2][4][2], const Unit& u, int wr, int wc, int fr, int fq) const {
        const int e = u.pn >> 3, pn = u.pn & 7; const int colg = pn * BM + wc * 32 + 8 * fq; const int row0 = u.pm * BM + wr * 64 + fr;
        f32x4 bv[2][2];
#pragma unroll
        for (int bj = 0; bj < 2; ++bj)
#pragma unroll
            for (int n = 0; n < 2; ++n) bv[bj][n] = *(const f32x4*)(bias + (size_t)e * 2048 + colg + bj * HALF + 4 * n);
#pragma unroll
        for (int ai = 0; ai < 2; ++ai)
#pragma unroll
            for (int m = 0; m < 4; ++m) { unsigned char* rowp = ACT + (size_t)(row0 + ai * HALF + m * 16) * 1024 + (colg >> 1);
#pragma unroll
                for (int bj = 0; bj < 2; ++bj) { const f32x4 v0 = acc[ai][bj][m][0] * sc_in + bv[bj][0], v1 = acc[ai][bj][m][1] * sc_in + bv[bj][1];
                    *(unsigned*)(rowp + bj * (HALF / 2)) = cvt4_fp8(swiglu1(v0[0], v0[1]) * sc_out, swiglu1(v0[2], v0[3]) * sc_out, swiglu1(v1[0], v1[1]) * sc_out, swiglu1(v1[2], v1[3]) * sc_out); } }
    } };
struct EpiDownG { static constexpr bool PERM = true, AFTER_DRAIN = false, MIDK = false; unsigned char* Y; const float* bias; const float* gs; const int* rowdst; float sc_in, sc_out;
    __device__ __forceinline__ void operator()(const f32x4 (&acc)[2][2][4][2], const Unit& u, int wr, int wc, int fr, int fq) const {
        const int e = u.pn >> 2, pn = u.pn & 3; const int col = pn * BM + wc * 32 + 8 * fq; const int row0 = u.pm * BM + wr * 64 + fr;
        f32x4 bv[2][2];
#pragma unroll
        for (int bj = 0; bj < 2; ++bj)
#pragma unroll
            for (int n = 0; n < 2; ++n) bv[bj][n] = *(const f32x4*)(bias + (size_t)e * 1024 + col + bj * HALF + 4 * n);
        int dstv[2][4]; float gv[2][4];
#pragma unroll
        for (int ai = 0; ai < 2; ++ai)
#pragma unroll
            for (int m = 0; m < 4; ++m) { const int row = row0 + ai * HALF + m * 16; dstv[ai][m] = rowdst[row]; gv[ai][m] = gs[row]; }
#pragma unroll
        for (int ai = 0; ai < 2; ++ai)
#pragma unroll
            for (int m = 0; m < 4; ++m) { const float g = gv[ai][m] * sc_out; const int dst = dstv[ai][m];
                if (dst >= 0) { unsigned char* rowp = Y + (size_t)dst * 1024 + col;
#pragma unroll
                    for (int bj = 0; bj < 2; ++bj) { const f32x4 v0 = (acc[ai][bj][m][0] * sc_in + bv[bj][0]) * g, v1 = (acc[ai][bj][m][1] * sc_in + bv[bj][1]) * g;
                        typedef unsigned u32x2v __attribute__((ext_vector_type(2))); u32x2v w; w.x = cvt4_fp8(v0[0], v0[1], v0[2], v0[3]); w.y = cvt4_fp8(v1[0], v1[1], v1[2], v1[3]);
                        *(u32x2v*)(rowp + bj * HALF) = w; } } }
    } };
struct EpiQKV { static constexpr bool PERM = true, AFTER_DRAIN = false, MIDK = false; bf16_t* O; size_t split_stride; float scale0; unsigned* kn2; const float* rs0;
    __device__ __forceinline__ void operator()(const f32x4 (&acc)[2][2][4][2], const Unit& u, int wr, int wc, int fr, int fq) const {
        const int row0 = u.pm * BM + wr * 64 + fr; int colt = u.pn * BM; const int t = colt / 1024; bf16_t* base = O + (size_t)t * split_stride; colt -= t * 1024; const float sc = (t == 0) ? scale0 : 1.f;
        const int col0 = colt + wc * 32 + 8 * fq;
        float mx[2] = {0.f, 0.f};
        float rsv[2][4];
#pragma unroll
        for (int ai = 0; ai < 2; ++ai)
#pragma unroll
            for (int m = 0; m < 4; ++m) rsv[ai][m] = rs0[row0 + ai * HALF + m * 16] * sc;
#pragma unroll
        for (int ai = 0; ai < 2; ++ai)
#pragma unroll
            for (int m = 0; m < 4; ++m) { bf16_t* rowp = base + (size_t)(row0 + ai * HALF + m * 16) * 1024 + col0; const float scr_ = rsv[ai][m];
#pragma unroll
                for (int bj = 0; bj < 2; ++bj) { const f32x4 v0 = acc[ai][bj][m][0] * scr_, v1 = acc[ai][bj][m][1] * scr_;
                    u32x4 w; w.x = cvt_pk_bf16(v0[0], v0[1]); w.y = cvt_pk_bf16(v0[2], v0[3]); w.z = cvt_pk_bf16(v1[0], v1[1]); w.w = cvt_pk_bf16(v1[2], v1[3]);
                    *(u32x4*)(rowp + bj * HALF) = w;
                    if (t == 1) { float s = (v0[0] * v0[0] + v0[1] * v0[1]) + (v0[2] * v0[2] + v0[3] * v0[3]) + (v1[0] * v1[0] + v1[1] * v1[1]) + (v1[2] * v1[2] + v1[3] * v1[3]);
                        s += __shfl_xor(s, 16); s += __shfl_xor(s, 32); mx[bj] = fmaxf(mx[bj], s); } } }
        if (t == 1) {
#pragma unroll
            for (int bj = 0; bj < 2; ++bj) { float m = mx[bj]; m = fmaxf(m, __shfl_xor(m, 1)); m = fmaxf(m, __shfl_xor(m, 2)); m = fmaxf(m, __shfl_xor(m, 4)); m = fmaxf(m, __shfl_xor(m, 8));
                if (fr == 0 && fq == 0) atomicMax(kn2 + ((u.pm >> 5) * 16 + (colt + bj * HALF) / 64 + (wc >> 1)) * 2 + (wc & 1), __float_as_uint(m)); } }
    } };
template <int MODE_>
struct GroupedOrderT {
    static constexpr int MODE = MODE_;
    const int* tile_e; int nN, base, nun, per, j; unsigned* tc; unsigned need;
    __device__ void init(const int* TILE, int nN_, int G_, int c_, unsigned* tc_, unsigned need_, int rot_units, int nt_hint = 0) {
        const int nt = nt_hint > 0 ? nt_hint : __builtin_amdgcn_readfirstlane(TILE[0]); tile_e = TILE + 16; nN = nN_; tc = tc_; need = need_;
        if (G_ % NXCD == 0) { const int x = c_ % NXCD, T0 = (x * nt) / NXCD, T1 = ((x + 1) * nt) / NXCD; per = G_ / NXCD; base = T0 * nN_; nun = (T1 - T0) * nN_;
            const int j0 = rot_units > 0 ? ((T1 - T0) * rot_units) % per : 0; j = (c_ / NXCD - j0 + per) % per; }
        else { per = G_; base = 0; nun = nt * nN_; j = c_; }
    }
    __device__ bool next(int i, Unit& u) const {
        const int l = i * per + j; if (l >= nun) return false;
        const int wgid = base + l; const int pm = wgid / nN, pn = wgid % nN; const int e = *(const __attribute__((address_space(4))) int*)(tile_e + pm);
        u.pm = pm; u.pn = e * nN + pn; return true;
    }
    __device__ __forceinline__ void done(const Unit&) const {}
    __device__ __forceinline__ unsigned flag_load(const Unit& u) const {
        if constexpr (MODE == 2) return *(const __attribute__((address_space(4))) unsigned*)(tc + u.pm * 8); else return 0u; }
    __device__ __forceinline__ void a_ready_pref(const Unit& u, unsigned fl) const {
        if constexpr (MODE == 2) { const unsigned* p = tc + u.pm * 8; unsigned t0_, t1_, tv_;
            asm volatile("s_cmp_eq_u32 %[fl], %[need]\n\t"
                         "s_cbranch_scc1 .Lrdy%=\n\t"
                         "s_mov_b32 %[t1], 0\n"
                         ".Lspin%=:\n\t"
                         "s_sleep 1\n\t"
                         "v_mov_b32 %[tv], 0\n\t"
                         "global_load_dword %[tv], %[tv], %[p] sc1\n\t"
                         "s_waitcnt vmcnt(0)\n\t"
                         "v_readfirstlane_b32 %[t0], %[tv]\n\t"
                         "s_add_u32 %[t1], %[t1], 1\n\t"
                         "s_cmp_eq_u32 %[t0], %[need]\n\t"
                         "s_cbranch_scc1 .Lrdy%=\n\t"
                         "s_bitcmp0_b32 %[t1], 22\n\t"
                         "s_cbranch_scc1 .Lspin%=\n"
                         ".Lrdy%=:"
                         : [t0] "=&s"(t0_), [t1] "=&s"(t1_), [tv] "=&v"(tv_) : [fl] "s"(fl), [p] "s"(p), [need] "s"(need) : "scc", "memory"); } }
    __device__ __forceinline__ void a_ready_first(const Unit& u) const {
        if constexpr (MODE == 2) {
            unsigned v, sp = 0u;
            for (;;) { v = (unsigned)__builtin_amdgcn_readfirstlane((int)__hip_atomic_load(tc + u.pm * 8, __ATOMIC_RELAXED, __HIP_MEMORY_SCOPE_AGENT)); if (v == need || ++sp > (1u << 22)) break; __builtin_amdgcn_s_sleep(1); }
            asm volatile("" ::: "memory");
        } }
    __device__ __forceinline__ void a_ready(const Unit& u) const { a_ready_first(u); }
    __device__ __forceinline__ void publish(int pm) const {
        if constexpr (MODE == 1) { if ((threadIdx.x & 63) == 0) (void)__hip_atomic_fetch_add(tc + pm * 8, 1u, __ATOMIC_RELAXED, __HIP_MEMORY_SCOPE_AGENT); } }
};
template <class Epi, class Sched, bool ALIGN_EPI = false, bool SP2 = false, bool GATHER = false, bool FP8 = false>
__device__ __forceinline__ void gemm_phase(PG8_LAS unsigned char* lds, const Gemm g, const Sched& S, const Epi& E, const int* rowtok = nullptr) {
    static_assert(!GATHER || SP2, "GATHER is written for the SP2 loop");
    const int tid = threadIdx.x, wid = __builtin_amdgcn_readfirstlane(tid >> 6), lane = tid & 63, wr = wid >> 2, wc = wid & 3, fr = lane & 15, fq = lane >> 4;
    const int K = g.K, nt = K / BK;
    unsigned voffA[2], voffB[2]; unsigned vA[2][2], nvA[2][2];
#pragma unroll
    for (int i = 0; i < 2; ++i) { int R, C; stage_rc(tid * 16 + i * 8192, R, C); const int Rb = Epi::PERM ? ((R & ~31) + perm32(R & 31)) : R;
        voffA[i] = (unsigned)(R * K + C) * 2u; voffB[i] = (unsigned)(Rb * K + C) * 2u; }
    const unsigned kstep = (unsigned)(BK * 2);
    const unsigned hstep = (unsigned)HALF * K * 2;
    const unsigned tstep = 2 * hstep, r64step = 64u * (unsigned)K * 2u;
    const __amdgpu_buffer_rsrc_t rsA = __builtin_amdgcn_make_buffer_rsrc((void*)g.A, 0, 0x7fffffff, 0x00020000), rsB = __builtin_amdgcn_make_buffer_rsrc((void*)g.Bt, 0, 0x7fffffff, 0x00020000);
    const unsigned ldsw = (unsigned)wid * 1024u;
    const int aoff = lds_byte(wr * 64 + fr, fq * 8), boff = lds_byte(wc * 32 + fr, fq * 8);
#define PG8_SA(b, h) (((b) * 2 + (h)) * HTB)
#define PG8_SB(b, h) ((4 + (b) * 2 + (h)) * HTB)
#define PG8_STAGE_R(rs, bufoff, soff, voff) do { _Pragma("unroll") for (int _i = 0; _i < 2; ++_i)     \
        __builtin_amdgcn_raw_ptr_buffer_load_lds(rs, (PG8_LAS unsigned*)(lds + (bufoff) + ldsw + _i * 8192), 16, (int)(voff)[0], (int)((soff) + _i * r64step), 0, 0); } while (0)
#define PG8_STAGE2(bufoff, soff, v0, v1) do { __builtin_amdgcn_raw_ptr_buffer_load_lds(rsA, (PG8_LAS unsigned*)(lds + (bufoff) + ldsw), 16, (int)(v0), (int)(soff), 0, 0); \
        __builtin_amdgcn_raw_ptr_buffer_load_lds(rsA, (PG8_LAS unsigned*)(lds + (bufoff) + ldsw + 8192), 16, (int)(v1), (int)(soff), 0, 0); } while (0)
#define PG8_STAGE_A(bufoff, h, gbase, nx) do { if constexpr (GATHER) { const unsigned s0_ = (nx) ? nvA[h][0] : vA[h][0], s1_ = (nx) ? nvA[h][1] : vA[h][1]; PG8_STAGE2(bufoff, gbase, s0_, s1_); } \
        else { PG8_STAGE_R(rsA, bufoff, (gbase) + ((h) ? hstep : 0u), voffA); } } while (0)
#define PG8_GATHER_OFFS(dst, un) do { _Pragma("unroll") for (int h_ = 0; h_ < 2; ++h_) _Pragma("unroll") for (int i_ = 0; i_ < 2; ++i_) \
        { int R_, C_; stage_rc(tid * 16 + i_ * 8192, R_, C_); dst[h_][i_] = (unsigned)rowtok[(un).pm * BM + h_ * HALF + R_] * (unsigned)(K * 2) + (unsigned)C_ * 2u; } } while (0)
#define PG8_GATHER_LOAD(dst, un) do { int tq_ = threadIdx.x; asm volatile("" : "+v"(tq_)); _Pragma("unroll") for (int h_ = 0; h_ < 2; ++h_) _Pragma("unroll") for (int i_ = 0; i_ < 2; ++i_) \
        { int R_, C_; stage_rc(tq_ * 16 + i_ * 8192, R_, C_); dst[h_][i_] = (unsigned)rowtok[(un).pm * BM + h_ * HALF + R_]; } } while (0)
#define PG8_GATHER_FIN(dst) do { int tq_ = threadIdx.x; asm volatile("" : "+v"(tq_)); _Pragma("unroll") for (int h_ = 0; h_ < 2; ++h_) _Pragma("unroll") for (int i_ = 0; i_ < 2; ++i_) \
        { int R_, C_; stage_rc(tq_ * 16 + i_ * 8192, R_, C_); dst[h_][i_] = dst[h_][i_] * (unsigned)(K * 2) + (unsigned)C_ * 2u; } } while (0)
#define PG8_LDA(dst, b, h) do { _Pragma("unroll") for (int m = 0; m < 4; ++m) _Pragma("unroll") for (int k = 0; k < 2; ++k) dst[m][k] = *(const PG8_LAS bf16x8*)(lds + PG8_SA(b, h) + aoff + m * 2048 + k * 1024); } while (0)
#define PG8_LDB(dst, b, h) do { _Pragma("unroll") for (int n = 0; n < 2; ++n) _Pragma("unroll") for (int k = 0; k < 2; ++k) dst[n][k] = *(const PG8_LAS bf16x8*)(lds + PG8_SB(b, h) + boff + n * 2048 + k * 1024); } while (0)
#define PG8_CAT8(x) __builtin_shufflevector(__builtin_bit_cast(i32x4_t, (x)[0]), __builtin_bit_cast(i32x4_t, (x)[1]), 0, 1, 2, 3, 4, 5, 6, 7)
#define PG8_MMA(ai, bj, At, Bt) do { __builtin_amdgcn_s_setprio(1); _Pragma("unroll") for (int m = 0; m < 4; ++m) _Pragma("unroll") for (int n = 0; n < 2; ++n) { \
        if constexpr (FP8) { acc[ai][bj][m][n] = __builtin_amdgcn_mfma_scale_f32_16x16x128_f8f6f4(PG8_CAT8(Bt[n]), PG8_CAT8(At[m]), acc[ai][bj][m][n], 0, 0, 0, 0, 0, 0); } \
        else { _Pragma("unroll") for (int k = 0; k < 2; ++k) acc[ai][bj][m][n] = __builtin_amdgcn_mfma_f32_16x16x32_bf16(Bt[n][k], At[m][k], acc[ai][bj][m][n], 0, 0, 0); } } \
        __builtin_amdgcn_s_setprio(0); } while (0)
#define PG8_WAIT_V(n) asm volatile("s_waitcnt vmcnt(" #n ")" ::: "memory")
#define PG8_WAIT_L(n) asm volatile("s_waitcnt lgkmcnt(" #n ")" ::: "memory")
#define PG8_BAR __builtin_amdgcn_s_barrier()
#define PG8_SCHED __builtin_amdgcn_sched_barrier(0)
    Unit cur, nxt; int ui = 0;
    if (!S.next(0, cur)) return;
    [[maybe_unused]] f32x4 pr_[4];
    if constexpr (Epi::MIDK) E.prep_load(cur, tid, pr_);
    f32x4 acc[2][2][4][2];
#pragma unroll
    for (int a = 0; a < 2; ++a)
#pragma unroll
        for (int b = 0; b < 2; ++b)
#pragma unroll
            for (int m = 0; m < 4; ++m)
#pragma unroll
                for (int n = 0; n < 2; ++n) { acc[a][b][m][n] = (f32x4){0.f, 0.f, 0.f, 0.f}; if constexpr (FP8) asm volatile("" : "+v"(acc[a][b][m][n])); }
    bf16x8 At[4][2], B0[2][2], B1[2][2];
    unsigned cA = GATHER ? 0u : (unsigned)cur.pm * tstep; unsigned cB = (unsigned)cur.pn * tstep;
    if constexpr (GATHER) { PG8_GATHER_OFFS(vA, cur); Unit n1_; if (S.next(1, n1_)) { PG8_GATHER_OFFS(nvA, n1_); } else { _Pragma("unroll") for (int h_ = 0; h_ < 2; ++h_) _Pragma("unroll") for (int i_ = 0; i_ < 2; ++i_) nvA[h_][i_] = vA[h_][i_]; } }
    S.a_ready(cur);
    if constexpr (SP2) {
        PG8_STAGE_R(rsB, PG8_SB(0, 0), cB, voffB); PG8_STAGE_R(rsB, PG8_SB(0, 1), cB + hstep, voffB); PG8_STAGE_A(PG8_SA(0, 0), 0, cA, false); PG8_STAGE_A(PG8_SA(0, 1), 1, cA, false);
        if (wr == 1) PG8_BAR;
        PG8_WAIT_V(2); PG8_BAR;
        PG8_STAGE_R(rsB, PG8_SB(1, 0), cB + kstep, voffB); PG8_STAGE_A(PG8_SA(1, 0), 0, cA + kstep, false); PG8_STAGE_R(rsB, PG8_SB(1, 1), cB + hstep + kstep, voffB);
        PG8_WAIT_V(6); PG8_BAR;
    } else {
        PG8_STAGE_R(rsB, PG8_SB(0, 0), cB, voffB); PG8_STAGE_R(rsA, PG8_SA(0, 0), cA, voffA); PG8_STAGE_R(rsB, PG8_SB(0, 1), cB + hstep, voffB); PG8_STAGE_R(rsA, PG8_SA(0, 1), cA + hstep, voffA);
        if (wr == 1) PG8_BAR;
        PG8_WAIT_V(4); PG8_BAR;
        PG8_STAGE_R(rsB, PG8_SB(1, 0), cB + kstep, voffB); PG8_STAGE_R(rsA, PG8_SA(1, 0), cA + kstep, voffA); PG8_STAGE_R(rsB, PG8_SB(1, 1), cB + hstep + kstep, voffB);
        PG8_WAIT_V(6); PG8_BAR;
    }
    if constexpr (Epi::MIDK) E.prep_fin(0, tid, pr_);
    int prev_pm = -1;
    for (;;) {
        const bool has_next = S.next(ui + 1, nxt);
        unsigned fl_ = 0u; if constexpr (Sched::MODE == 2) { if (has_next) fl_ = S.flag_load(nxt); }
        if constexpr (Epi::MIDK) { if (has_next) E.prep(nxt, (ui + 1) & 1, tid); }
        const unsigned nA = GATHER ? 0u : (has_next ? (unsigned)nxt.pm * tstep : cA); const unsigned nB = has_next ? (unsigned)nxt.pn * tstep : cB;
        for (int t = 0; t < nt; t += 2) {
            const bool last = (t == nt - 2);
            const unsigned a1 = cA + (unsigned)(t + 1) * kstep;
            const unsigned a2 = last ? nA : cA + (unsigned)(t + 2) * kstep; const unsigned b2 = last ? nB : cB + (unsigned)(t + 2) * kstep;
            const unsigned a3 = a2 + kstep; const unsigned b3 = b2 + kstep;
            if constexpr (Sched::MODE == 2) { if (last && has_next) S.a_ready_pref(nxt, fl_); }
            else { if (last && has_next) S.a_ready(nxt); }
            if constexpr (SP2) {
            PG8_LDB(B0, 0, 0); PG8_LDB(B1, 0, 1); PG8_SCHED; PG8_LDA(At, 0, 0); PG8_STAGE_A(PG8_SA(1, 1), 1, a1, false);
            PG8_WAIT_V(8); PG8_WAIT_L(0); PG8_BAR; PG8_MMA(0, 0, At, B0); PG8_MMA(0, 1, At, B1); PG8_BAR; PG8_SCHED;
            PG8_LDA(At, 0, 1); PG8_STAGE_R(rsB, PG8_SB(0, 0), b2, voffB); PG8_STAGE_R(rsB, PG8_SB(0, 1), b2 + hstep, voffB); PG8_STAGE_A(PG8_SA(0, 0), 0, a2, last);
            PG8_WAIT_V(8); PG8_WAIT_L(0); PG8_BAR; PG8_MMA(1, 0, At, B0); PG8_MMA(1, 1, At, B1); PG8_BAR; PG8_SCHED;
            PG8_LDB(B0, 1, 0); PG8_LDB(B1, 1, 1); PG8_SCHED; PG8_LDA(At, 1, 0); PG8_STAGE_A(PG8_SA(0, 1), 1, a2, last);
            PG8_WAIT_V(8); PG8_WAIT_L(0); PG8_BAR; PG8_MMA(0, 0, At, B0); PG8_MMA(0, 1, At, B1); PG8_BAR; PG8_SCHED;
            PG8_LDA(At, 1, 1); PG8_STAGE_R(rsB, PG8_SB(1, 0), b3, voffB); PG8_STAGE_R(rsB, PG8_SB(1, 1), b3 + hstep, voffB); PG8_STAGE_A(PG8_SA(1, 0), 0, a3, last);
            PG8_WAIT_V(8); PG8_WAIT_L(0); PG8_BAR; PG8_MMA(1, 0, At, B0); PG8_MMA(1, 1, At, B1); PG8_BAR; PG8_SCHED;
            } else {
            PG8_LDB(B0, 0, 0); PG8_SCHED; PG8_LDA(At, 0, 0); PG8_STAGE_R(rsA, PG8_SA(1, 1), a1 + hstep, voffA);
            PG8_WAIT_L(8); PG8_BAR; PG8_WAIT_L(0); PG8_MMA(0, 0, At, B0); PG8_BAR; PG8_SCHED;
            PG8_LDB(B1, 0, 1); PG8_STAGE_R(rsB, PG8_SB(0, 0), b2, voffB);
            PG8_BAR; PG8_WAIT_L(0); PG8_MMA(0, 1, At, B1); PG8_BAR;
            PG8_LDA(At, 0, 1); PG8_STAGE_R(rsA, PG8_SA(0, 0), a2, voffA);
            PG8_BAR; PG8_WAIT_L(0); PG8_MMA(1, 0, At, B0); PG8_BAR; PG8_SCHED;
            PG8_STAGE_R(rsB, PG8_SB(0, 1), b2 + hstep, voffB);
            PG8_WAIT_V(6); PG8_BAR; PG8_MMA(1, 1, At, B1); PG8_BAR;
            PG8_LDB(B0, 1, 0); PG8_SCHED; PG8_LDA(At, 1, 0); PG8_STAGE_R(rsA, PG8_SA(0, 1), a2 + hstep, voffA);
            PG8_WAIT_L(8); PG8_BAR; PG8_WAIT_L(0); PG8_MMA(0, 0, At, B0); PG8_BAR; PG8_SCHED;
            PG8_LDB(B1, 1, 1); PG8_STAGE_R(rsB, PG8_SB(1, 0), b3, voffB);
            PG8_BAR; PG8_WAIT_L(0); PG8_MMA(0, 1, At, B1); PG8_BAR;
            PG8_LDA(At, 1, 1); PG8_STAGE_R(rsA, PG8_SA(1, 0), a3, voffA);
            PG8_BAR; PG8_WAIT_L(0); PG8_MMA(1, 0, At, B0); PG8_BAR; PG8_SCHED;
            PG8_STAGE_R(rsB, PG8_SB(1, 1), b3 + hstep, voffB);
            PG8_WAIT_V(6); PG8_BAR; PG8_MMA(1, 1, At, B1); PG8_BAR;
            }
            if constexpr (Epi::MIDK) { if (t == nt / 2 - 2) E.midk(acc, ui & 1, wr, fr); }
        }
        if constexpr (ALIGN_EPI) { if (wr == 0) PG8_BAR; }
        [[maybe_unused]] bool has_nn = false;
        if constexpr (GATHER) { Unit nn_; has_nn = has_next && S.next(ui + 2, nn_); if (has_nn) { PG8_GATHER_LOAD(vA, nn_); } }
        if constexpr (Sched::MODE == 1) { if (nt >= 4 && prev_pm >= 0) S.publish(prev_pm); }
        int l_e; asm volatile("v_mbcnt_lo_u32_b32 %0, -1, 0\n\tv_mbcnt_hi_u32_b32 %0, -1, %0" : "=v"(l_e)); const int fr_e = l_e & 15, fq_e = l_e >> 4;
        if constexpr (Epi::MIDK) { E.epi(acc, cur, ui & 1, wr, wc, fr_e, fq_e); S.done(cur); }
        else if constexpr (!Epi::AFTER_DRAIN) { E(acc, cur, wr, wc, fr_e, fq_e); S.done(cur); }
        if constexpr (Sched::MODE == 1) { if (nt < 4) { PG8_WAIT_V(0); S.publish(cur.pm); } else prev_pm = cur.pm; }
        if (!has_next) break;
#pragma unroll
        for (int a = 0; a < 2; ++a)
#pragma unroll
            for (int b = 0; b < 2; ++b)
#pragma unroll
                for (int m = 0; m < 4; ++m)
#pragma unroll
                    for (int n = 0; n < 2; ++n) { acc[a][b][m][n] = (f32x4){0.f, 0.f, 0.f, 0.f}; if constexpr (FP8) asm volatile("" : "+v"(acc[a][b][m][n])); }
        cur = nxt; cA = nA; cB = nB; ++ui;
        if constexpr (GATHER) { if (has_nn) { PG8_GATHER_FIN(vA); } else { _Pragma("unroll") for (int h_ = 0; h_ < 2; ++h_) _Pragma("unroll") for (int i_ = 0; i_ < 2; ++i_) vA[h_][i_] = nvA[h_][i_]; }
            _Pragma("unroll") for (int h_ = 0; h_ < 2; ++h_) _Pragma("unroll") for (int i_ = 0; i_ < 2; ++i_) { const unsigned t_ = vA[h_][i_]; vA[h_][i_] = nvA[h_][i_]; nvA[h_][i_] = t_; } }
        if constexpr (ALIGN_EPI) { if (wr == 1) PG8_BAR; }
    }
    PG8_WAIT_V(0);
    if constexpr (Sched::MODE == 1) { if (prev_pm >= 0) S.publish(prev_pm); }
    if constexpr (!ALIGN_EPI) { if (wr == 0) PG8_BAR; }
    PG8_BAR;
    if constexpr (Epi::AFTER_DRAIN) { E.fused(acc, cur, wr, wc, fr, fq, lds, wid, lane); S.done(cur); }
#undef PG8_SA
#undef PG8_SB
#undef PG8_STAGE_R
#undef PG8_STAGE2
#undef PG8_STAGE_A
#undef PG8_GATHER_OFFS
#undef PG8_GATHER_LOAD
#undef PG8_GATHER_FIN
#undef PG8_LDA
#undef PG8_LDB
#undef PG8_MMA
#undef PG8_CAT8
#undef PG8_WAIT_V
#undef PG8_WAIT_L
#undef PG8_BAR
#undef PG8_SCHED
}
}

namespace att {
typedef short bf16x8 __attribute__((ext_vector_type(8)));
typedef short s16x4 __attribute__((ext_vector_type(4)));
typedef float f32x16 __attribute__((ext_vector_type(16)));
typedef float f32x4 __attribute__((ext_vector_type(4)));
typedef unsigned u32x4 __attribute__((ext_vector_type(4)));
typedef unsigned u32x2 __attribute__((ext_vector_type(2)));
typedef short v4i16_t __attribute__((ext_vector_type(4)));
typedef __attribute__((address_space(3))) const char* lds_cptr;
constexpr int DM = 1024, SLOTB = 8192;
constexpr int NSLOT = 8, DIST = 4;
constexpr int L_K = 0, L_V = NSLOT * SLOTB, L_B = 2 * NSLOT * SLOTB, L_DONE = L_B + NSLOT * 256, L_BYTES = L_DONE + 64;
constexpr float FOX_THR = 40.f, SB_THR = 32.f;
__device__ __forceinline__ int crow(int r, int hi) { return (r & 3) + 8 * (r >> 2) + 4 * hi; }
__device__ __forceinline__ void glds16(const void* gsrc, unsigned lds_dst) { unsigned keep;
    asm volatile("s_mov_b32 %0, m0\n\ts_mov_b32 m0, %2\n\ts_nop 0\n\tglobal_load_lds_dwordx4 %1, off\n\ts_mov_b32 m0, %0" : "=&s"(keep) : "v"(gsrc), "s"(lds_dst) : "memory"); }
__device__ __forceinline__ void glds4(const void* gsrc, unsigned lds_dst) { unsigned keep;
    asm volatile("s_mov_b32 %0, m0\n\ts_mov_b32 m0, %2\n\ts_nop 0\n\tglobal_load_lds_dword %1, off\n\ts_mov_b32 m0, %0" : "=&s"(keep) : "v"(gsrc), "s"(lds_dst) : "memory"); }
typedef float f32x2_t __attribute__((ext_vector_type(2))); typedef __bf16 bf16x2_t __attribute__((ext_vector_type(2)));
__device__ __forceinline__ unsigned cvtpk(float lo, float hi) { f32x2_t v = {lo, hi}; bf16x2_t b = __builtin_convertvector(v, bf16x2_t); return __builtin_bit_cast(unsigned, b); }
__device__ __forceinline__ s16x4 vtr(lds_cptr p) { return __builtin_bit_cast(s16x4, __builtin_amdgcn_ds_read_tr16_b64_v4i16((__attribute__((address_space(3))) v4i16_t*)p)); }
#define ATT_WAIT_BAR() asm volatile("s_waitcnt vmcnt(0) lgkmcnt(0)\n\ts_barrier" ::: "memory")
#define ATT_BAR() asm volatile("s_barrier" ::: "memory")
#define ATT_LBAR() asm volatile("s_waitcnt lgkmcnt(0)\n\ts_barrier" ::: "memory")
#define ATT_WAITV_BAR(n) asm volatile("s_waitcnt vmcnt(" #n ") lgkmcnt(0)\n\ts_barrier" ::: "memory")
__device__ __forceinline__ float max3f(float a, float b, float c) { float r; asm("v_max3_f32 %0, %1, %2, %3" : "=v"(r) : "v"(a), "v"(b), "v"(c)); return r; }

constexpr int G_SLOTS = 4;
constexpr int G_K = 0, G_V = G_SLOTS * SLOTB, G_B = 2 * G_SLOTS * SLOTB, G_DONE = G_B + G_SLOTS * 256, G_ARR = G_DONE + 64, G_BYTES = G_ARR + 64;
typedef volatile __attribute__((address_space(3))) unsigned* lds_vu32;
__device__ __forceinline__ void grp_barrier(lds_vu32 arr, unsigned& epoch, int wid, int lane) {
    ++epoch;
    if (lane == 0) arr[wid] = epoch;
    for (;;) { const unsigned v = (lane < 4) ? arr[lane] : epoch; if (__all(v >= epoch)) break; __builtin_amdgcn_s_sleep(0); }
    asm volatile("" ::: "memory");
}
#define G_WAITV(n) asm volatile("s_waitcnt vmcnt(" #n ") lgkmcnt(0)" ::: "memory")
template <bool FOX, bool PRUNE>
__device__ __forceinline__ void attn_unit4(int b, int h16, int qb, const bf16* QO, bf16* F_O, const bf16* __restrict__ K, const bf16* __restrict__ V, float* SSQ, const float* CLrow, float KN, char* shm, unsigned& epoch) {
    const int tid = threadIdx.x, lane = tid & 63, r32 = lane & 31, hi = lane >> 5; const int wid = __builtin_amdgcn_readfirstlane((tid >> 6) & 3);
    const long rowbase = (long)b * SEQ; const int q0 = qb * 128;
    const bf16* Qw = QO + (rowbase + q0 + wid * 32) * DM + h16 * 64;
    const bf16* Kh = K + rowbase * DM + h16 * 64; const bf16* Vh = V + rowbase * DM + h16 * 64;
    const unsigned lds0 = (unsigned)(uintptr_t)shm;
    const bf16* ksrc = Kh + (long)(8 * wid + (lane >> 3)) * DM + (((lane & 7) ^ (lane >> 3)) * 8);
    const bf16* vsrc = Vh + (long)(16 * wid + (lane >> 2)) * DM + (lane & 3) * 8;
    const unsigned kdst = lds0 + G_K + wid * 1024, vdst = lds0 + G_V + wid * 1024, bdst = lds0 + G_B;
    const lds_cptr shm3 = (lds_cptr)shm;
    const lds_cptr kp0 = shm3 + G_K + r32 * 128; const int kx = ((r32 & 7) ^ hi) << 4;
    const lds_cptr vp0 = shm3 + G_V + ((lane >> 4) & 1) * 32 + (lane & 3) * 8 + (4 * hi + ((lane & 15) >> 2)) * 64;
    volatile __attribute__((address_space(3))) int* done_at = (volatile __attribute__((address_space(3))) int*)(shm3 + G_DONE);
    lds_vu32 arr = (lds_vu32)(shm3 + G_ARR);
    const int NT = (q0 + 128) / 64;
#define G_DMA(t, slot) do { glds16(ksrc + (long)(t) * 64 * DM, (unsigned)__builtin_amdgcn_readfirstlane(kdst + (slot) * SLOTB)); glds16(ksrc + (long)((t) * 64 + 32) * DM, (unsigned)__builtin_amdgcn_readfirstlane(kdst + 4096 + (slot) * SLOTB)); \
        glds16(vsrc + (long)(t) * 64 * DM, (unsigned)__builtin_amdgcn_readfirstlane(vdst + (slot) * SLOTB)); glds16(vsrc + (long)(t) * 64 * DM + 32, (unsigned)__builtin_amdgcn_readfirstlane(vdst + 4096 + (slot) * SLOTB)); \
        if (FOX) glds4(CLrow + (t) * 64 + lane, (unsigned)__builtin_amdgcn_readfirstlane(bdst + (slot) * 256)); } while (0)
    bf16x8 qr[4];
#pragma unroll
    for (int d0 = 0; d0 < 4; ++d0) qr[d0] = *reinterpret_cast<const bf16x8*>(&Qw[(long)r32 * DM + d0 * 16 + hi * 8]);
    float qn = 0.f;
    if (FOX && PRUNE) {
#pragma unroll
        for (int d0 = 0; d0 < 4; ++d0)
#pragma unroll
            for (int j = 0; j < 8; ++j) { const float v = __builtin_bit_cast(float, (unsigned)(unsigned short)qr[d0][j] << 16); qn += v * v; }
        qn += __shfl_xor(qn, 32); qn = sqrtf(qn) * KN;
    }
    const float clref = FOX ? CLrow[q0 + wid * 32] : 0.f;
    const int qrel = wid * 32 + r32;
    asm volatile("" :: "v"(qr[0]), "v"(qr[1]), "v"(qr[2]), "v"(qr[3]), "v"(clref), "v"(qn));
    G_WAITV(0); grp_barrier(arr, epoch, wid, lane);
    if (lane == 0) done_at[wid] = 0x7fffffff;
    G_DMA(NT - 1, 0); G_DMA(NT - 2, 1);
    f32x16 o0 = {}, o1 = {}, lacc = {};
    float mref = 0.f, R = 0.f;
    bool mydone = false, posted = false, first = true;
    bf16x8 U0, U1, ONES;
#pragma unroll
    for (int j = 0; j < 8; ++j) { const int kk = 8 * (j >> 2) + 4 * hi + (j & 3); U0[j] = (kk > r32) ? (short)0x3f80 : (short)0; U1[j] = (16 + kk > r32) ? (short)0x3f80 : (short)0; ONES[j] = (short)0x3f80; }
    for (int i = 0;; ++i) {
        const int t = NT - 1 - i, slot = i & (G_SLOTS - 1);
        if (t < 0) break;
        { const int ahead = t < 1 ? t : 1;
          if (FOX) { if (ahead == 1) G_WAITV(5); else G_WAITV(0); }
          else     { if (ahead == 1) G_WAITV(4); else G_WAITV(0); } }
        grp_barrier(arr, epoch, wid, lane);
        if (i > 0) { const int da = done_at[lane & 3]; if (__all(da <= i - 1)) break; }
        if (t >= 2) G_DMA(t - 2, (i + 2) & (G_SLOTS - 1));
        const int jb = t - (NT - 2);
        if (!mydone && !(jb >= 0 && 2 * jb > wid)) {
            const lds_cptr kp = kp0 + slot * SLOTB; const lds_cptr vp = vp0 + slot * SLOTB;
            bf16x8 kf[8];
#pragma unroll
            for (int d0 = 0; d0 < 4; ++d0) { const int ko = kx ^ (d0 << 5); kf[2 * d0] = *(const __attribute__((address_space(3))) bf16x8*)(kp + ko); kf[2 * d0 + 1] = *(const __attribute__((address_space(3))) bf16x8*)(kp + ko + 4096); }
            const bool need_mask = __builtin_amdgcn_readfirstlane((int)(jb >= 0 && 64 * jb + 63 > 32 * wid)) != 0;
            f32x16 p0, p1; float bias00 = 0.f;
            if (FOX) {
                const __attribute__((address_space(3))) f32x4* bp = (const __attribute__((address_space(3))) f32x4*)(shm3 + G_B + slot * 256);
                const float cm = clref - mref;
#pragma unroll
                for (int g = 0; g < 4; ++g) { const f32x4 c0 = bp[2 * g + hi], c1 = bp[8 + 2 * g + hi];
#pragma unroll
                    for (int e = 0; e < 4; ++e) { p0[4 * g + e] = cm - c0[e]; p1[4 * g + e] = cm - c1[e]; } }
                bias00 = clref - bp[0][0];
            } else { p0 = f32x16{}; p1 = f32x16{}; }
#pragma unroll
            for (int d0 = 0; d0 < 4; ++d0) { p0 = __builtin_amdgcn_mfma_f32_32x32x16_bf16(kf[2 * d0], qr[d0], p0, 0, 0, 0); p1 = __builtin_amdgcn_mfma_f32_32x32x16_bf16(kf[2 * d0 + 1], qr[d0], p1, 0, 0, 0); }
            s16x4 vlo[8], vhi[8];
#pragma unroll
            for (int q = 0; q < 8; ++q) { vlo[q] = vtr(vp + ((q >> 2) * 4096 + (q & 3) * 1024)); vhi[q] = vtr(vp + ((q >> 2) * 4096 + (q & 3) * 1024 + 512)); }
            if (FOX) asm volatile("s_nop 15\n\ts_nop 7" : "+v"(p0), "+v"(p1));
            if (FOX) {
                if (need_mask) { asm volatile("" ::: "memory");
#pragma unroll
                    for (int r = 0; r < 16; ++r) { const int kv = 64 * jb + crow(r, hi); if (kv > qrel) p0[r] = -INFINITY; if (kv + 32 > qrel) p1[r] = -INFINITY; } }
                float ma = max3f(p0[0], p1[0], p0[1]), mb = max3f(p1[1], p0[2], p1[2]);
#pragma unroll
                for (int r = 3; r < 15; r += 2) { ma = max3f(ma, p0[r], p1[r]); mb = max3f(mb, p0[r + 1], p1[r + 1]); }
                ma = max3f(ma, p0[15], p1[15]);
                float mt = max3f(ma, mb, mb); mt = max3f(mt, __shfl_xor(mt, 32), mt);
                if (first || __any(mt > 0.f)) {
                    const float d = first ? mt : fmaxf(mt, 0.f); mref += d;
                    if (!first) { const float alpha = __builtin_amdgcn_exp2f(-d);
#pragma unroll
                        for (int r = 0; r < 16; ++r) { o0[r] *= alpha; o1[r] *= alpha; }
                        lacc[0] *= alpha; }
#pragma unroll
                    for (int r = 0; r < 16; ++r) { p0[r] -= d; p1[r] -= d; }
                    first = false;
                }
#pragma unroll
                for (int r = 0; r < 16; ++r) { p0[r] = __builtin_amdgcn_exp2f(p0[r]); p1[r] = __builtin_amdgcn_exp2f(p1[r]); }
                if (t == 0) mydone = true;
                else if (PRUNE) mydone = __all(qn + bias00 - mref < -FOX_THR);
            } else {
                f32x16 x0, x1;
#pragma unroll
                for (int r = 0; r < 16; ++r) {
                    { const float z = p0[r]; const float sp = __builtin_amdgcn_logf(1.f + __builtin_amdgcn_exp2f(-fabsf(z))); const float lb = fminf(z, 0.f) - sp; p0[r] = lb; x0[r] = lb - z; }
                    { const float z = p1[r]; const float sp = __builtin_amdgcn_logf(1.f + __builtin_amdgcn_exp2f(-fabsf(z))); const float lb = fminf(z, 0.f) - sp; p1[r] = lb; x1[r] = lb - z; } }
                if (need_mask) { asm volatile("" ::: "memory");
#pragma unroll
                    for (int r = 0; r < 16; ++r) { const int kv = 64 * jb + crow(r, hi); if (kv >= qrel) { p0[r] = -INFINITY; x0[r] = 0.f; } if (kv + 32 >= qrel) { p1[r] = -INFINITY; x1[r] = 0.f; } } }
                u32x4 xw0, xw1, xw2, xw3;
                xw0 = (u32x4){cvtpk(x0[0], x0[1]), cvtpk(x0[2], x0[3]), cvtpk(x0[4], x0[5]), cvtpk(x0[6], x0[7])}; xw1 = (u32x4){cvtpk(x0[8], x0[9]), cvtpk(x0[10], x0[11]), cvtpk(x0[12], x0[13]), cvtpk(x0[14], x0[15])};
                xw2 = (u32x4){cvtpk(x1[0], x1[1]), cvtpk(x1[2], x1[3]), cvtpk(x1[4], x1[5]), cvtpk(x1[6], x1[7])}; xw3 = (u32x4){cvtpk(x1[8], x1[9]), cvtpk(x1[10], x1[11]), cvtpk(x1[12], x1[13]), cvtpk(x1[14], x1[15])};
                p1 = __builtin_amdgcn_mfma_f32_32x32x16_bf16(U0, __builtin_bit_cast(bf16x8, xw2), p1, 0, 0, 0);
                p1 = __builtin_amdgcn_mfma_f32_32x32x16_bf16(U1, __builtin_bit_cast(bf16x8, xw3), p1, 0, 0, 0);
                p0 = __builtin_amdgcn_mfma_f32_32x32x16_bf16(U0, __builtin_bit_cast(bf16x8, xw0), p0, 0, 0, 0);
                p0 = __builtin_amdgcn_mfma_f32_32x32x16_bf16(U1, __builtin_bit_cast(bf16x8, xw1), p0, 0, 0, 0);
                p0 = __builtin_amdgcn_mfma_f32_32x32x16_bf16(ONES, __builtin_bit_cast(bf16x8, xw2), p0, 0, 0, 0);
                p0 = __builtin_amdgcn_mfma_f32_32x32x16_bf16(ONES, __builtin_bit_cast(bf16x8, xw3), p0, 0, 0, 0);
                f32x16 tt = __builtin_amdgcn_mfma_f32_32x32x16_bf16(ONES, __builtin_bit_cast(bf16x8, xw0), f32x16{}, 0, 0, 0);
                tt = __builtin_amdgcn_mfma_f32_32x32x16_bf16(ONES, __builtin_bit_cast(bf16x8, xw1), tt, 0, 0, 0);
                tt = __builtin_amdgcn_mfma_f32_32x32x16_bf16(ONES, __builtin_bit_cast(bf16x8, xw2), tt, 0, 0, 0);
                tt = __builtin_amdgcn_mfma_f32_32x32x16_bf16(ONES, __builtin_bit_cast(bf16x8, xw3), tt, 0, 0, 0);
#pragma unroll
                for (int r = 0; r < 16; ++r) { p0[r] = __builtin_amdgcn_exp2f(p0[r] + R); p1[r] = __builtin_amdgcn_exp2f(p1[r] + R); }
                R += tt[0];
                if (t == 0) mydone = true;
                else if (PRUNE) mydone = __all(R < -SB_THR);
            }
            u32x4 pw0, pw1, pw2, pw3;
            pw0 = (u32x4){cvtpk(p0[0], p0[1]), cvtpk(p0[2], p0[3]), cvtpk(p0[4], p0[5]), cvtpk(p0[6], p0[7])}; pw1 = (u32x4){cvtpk(p0[8], p0[9]), cvtpk(p0[10], p0[11]), cvtpk(p0[12], p0[13]), cvtpk(p0[14], p0[15])};
            pw2 = (u32x4){cvtpk(p1[0], p1[1]), cvtpk(p1[2], p1[3]), cvtpk(p1[4], p1[5]), cvtpk(p1[6], p1[7])}; pw3 = (u32x4){cvtpk(p1[8], p1[9]), cvtpk(p1[10], p1[11]), cvtpk(p1[12], p1[13]), cvtpk(p1[14], p1[15])};
#define G_PV(OACC, DH, KS, PW) do { const bf16x8 vf_ = (bf16x8){vlo[(DH) * 4 + (KS)][0], vlo[(DH) * 4 + (KS)][1], vlo[(DH) * 4 + (KS)][2], vlo[(DH) * 4 + (KS)][3], vhi[(DH) * 4 + (KS)][0], vhi[(DH) * 4 + (KS)][1], vhi[(DH) * 4 + (KS)][2], vhi[(DH) * 4 + (KS)][3]}; \
                OACC = __builtin_amdgcn_mfma_f32_32x32x16_bf16(vf_, __builtin_bit_cast(bf16x8, PW), OACC, 0, 0, 0); } while (0)
            G_PV(o0, 0, 0, pw0); G_PV(o1, 1, 0, pw0); G_PV(o0, 0, 1, pw1); G_PV(o1, 1, 1, pw1);
            G_PV(o0, 0, 2, pw2); G_PV(o1, 1, 2, pw2); G_PV(o0, 0, 3, pw3); G_PV(o1, 1, 3, pw3);
#undef G_PV
            if (FOX) { lacc = __builtin_amdgcn_mfma_f32_32x32x16_bf16(ONES, __builtin_bit_cast(bf16x8, pw0), lacc, 0, 0, 0); lacc = __builtin_amdgcn_mfma_f32_32x32x16_bf16(ONES, __builtin_bit_cast(bf16x8, pw1), lacc, 0, 0, 0);
                       lacc = __builtin_amdgcn_mfma_f32_32x32x16_bf16(ONES, __builtin_bit_cast(bf16x8, pw2), lacc, 0, 0, 0); lacc = __builtin_amdgcn_mfma_f32_32x32x16_bf16(ONES, __builtin_bit_cast(bf16x8, pw3), lacc, 0, 0, 0); }
        }
        if (t == 0) mydone = true;
        if (mydone && !posted) { if (lane == 0) done_at[wid] = i; posted = true; }
    }
#undef G_DMA
    float inv = 1.f;
    if (FOX) inv = 1.f / lacc[0];
    float ssq = 0.f;
#pragma unroll
    for (int r = 0; r < 16; ++r) { o0[r] *= inv; o1[r] *= inv; ssq += o0[r] * o0[r] + o1[r] * o1[r]; }
    ssq += __shfl_xor(ssq, 32);
    if (hi == 0) SSQ[(size_t)(rowbase + q0 + qrel) * 16 + h16] = ssq;
    bf16* orow = F_O + (rowbase + q0 + wid * 32 + r32) * DM + h16 * 64;
#pragma unroll
    for (int g = 0; g < 4; ++g) {
        u32x2 w0 = {cvtpk(o0[4 * g], o0[4 * g + 1]), cvtpk(o0[4 * g + 2], o0[4 * g + 3])}, w1 = {cvtpk(o1[4 * g], o1[4 * g + 1]), cvtpk(o1[4 * g + 2], o1[4 * g + 3])};
        *(u32x2*)(orow + 8 * g + 4 * hi) = w0; *(u32x2*)(orow + 32 + 8 * g + 4 * hi) = w1; }
}
#undef G_WAITV
}

#define XB_TMO      128
#define XB_XCNT(j)  (256  + 64 * (j))
#define XB_XSUB(j)  (1280 + 64 * (j))
#define XB_XGEN(j)  (2304 + 64 * (j))
#define XB_TOP      3328
#define XB_TOPGEN   3392
#define XCD_BAR_WORDS 3456
#define XB_SPIN_CAP (1u << 21)
__device__ __forceinline__ unsigned xb_ld(unsigned* p)              { return __hip_atomic_load(p, __ATOMIC_RELAXED, __HIP_MEMORY_SCOPE_AGENT); }
__device__ __forceinline__ unsigned xb_add(unsigned* p, unsigned v) { return __hip_atomic_fetch_add(p, v, __ATOMIC_RELAXED, __HIP_MEMORY_SCOPE_AGENT); }
__device__ __forceinline__ unsigned xb_xcc_id() { return (unsigned)__builtin_amdgcn_s_getreg((3 << 11) | 20) & 0xFu; }
#define XB_SPIN(cond, bar) do { unsigned _sp = 0; while (cond) { __builtin_amdgcn_s_sleep(1); \
    if ((++_sp & 255u) == 0u) { if (xb_ld(&(bar)[XB_TMO])) break; if (_sp > XB_SPIN_CAP) { atomicAdd(&(bar)[XB_TMO], 1u); break; } } } } while (0)
struct XcdBarrier { unsigned* bar; unsigned x; volatile LAS unsigned* st; };
__device__ __forceinline__ XcdBarrier xcd_barrier_post(unsigned* bar, volatile LAS unsigned* st) {
    XcdBarrier b; b.bar = bar; b.x = xb_xcc_id(); b.st = st;
    if (threadIdx.x == 0) (void)xb_add(&bar[XB_XCNT(b.x)], 1u);
    return b;
}
__device__ __forceinline__ void xcd_barrier_complete(unsigned* bar, unsigned x, unsigned& nloc, unsigned& nx) {
    const unsigned G = gridDim.x * gridDim.y * gridDim.z;
    unsigned sum, cnt, mine, sp = 0u;
    for (;;) {
        sum = 0u; cnt = 0u; mine = 0u;
#pragma unroll
        for (unsigned j = 0; j < 16; ++j) { const unsigned c = xb_ld(&bar[XB_XCNT(j)]); sum += c; cnt += (c > 0u) ? 1u : 0u; mine = (j == x) ? c : mine; }
        if (sum == G) break;
        __builtin_amdgcn_s_sleep(1);
        if ((++sp & 255u) == 0u) { if (xb_ld(&bar[XB_TMO])) break; if (sp > XB_SPIN_CAP) { atomicAdd(&bar[XB_TMO], 1u); break; } }
    }
    nloc = mine > 0u ? mine : 1u; nx = cnt > 0u ? cnt : 1u;
}
__device__ __forceinline__ void xcd_barrier_proto(const XcdBarrier& b) {
    {
        unsigned* bar = b.bar;
        __builtin_amdgcn_s_waitcnt(0);
        unsigned nloc = b.st[0], nx = b.st[1];
        if (nloc == 0u) { xcd_barrier_complete(bar, b.x, nloc, nx); b.st[0] = nloc; b.st[1] = nx; }
        const unsigned old = xb_add(&bar[XB_XSUB(b.x)], 1u);
        const unsigned gen = old / nloc;
        if (old + 1u == (gen + 1u) * nloc) {
            __builtin_amdgcn_fence(__ATOMIC_RELEASE, "agent");
            asm volatile("s_waitcnt vmcnt(0)" ::: "memory");
            const unsigned og = xb_add(&bar[XB_TOP], 1u);
            const unsigned tg = og / nx;
            if (og + 1u == (tg + 1u) * nx) xb_add(&bar[XB_TOPGEN], 1u);
            else XB_SPIN(xb_ld(&bar[XB_TOPGEN]) == tg, bar);
            __builtin_amdgcn_fence(__ATOMIC_ACQUIRE, "agent");
            xb_add(&bar[XB_XGEN(b.x)], 1u);
            asm volatile("s_waitcnt vmcnt(0)" ::: "memory");
        } else {
            XB_SPIN(xb_ld(&bar[XB_XGEN(b.x)]) == gen, bar);
            __builtin_amdgcn_fence(__ATOMIC_ACQUIRE, "agent");
            asm volatile("s_waitcnt vmcnt(0)" ::: "memory");
        }
    }
}
__device__ __forceinline__ void xcd_barrier(const XcdBarrier& b) {
    asm volatile("s_waitcnt vmcnt(0)" ::: "memory");
    __syncthreads();
    if (threadIdx.x == 0) xcd_barrier_proto(b);
    __syncthreads();
}
template <class Work>
__device__ __forceinline__ void xcd_barrier_work(const XcdBarrier& b, Work work) {
    asm volatile("s_waitcnt vmcnt(0)" ::: "memory");
    __syncthreads();
    if (threadIdx.x < 64) { if (threadIdx.x == 0) xcd_barrier_proto(b); }
    else work();
    __syncthreads();
}

struct Args { const float* in[15]; float* out; unsigned char* ws; int ph_lo, ph_hi; };
__device__ __forceinline__ int hw_lane() { return (int)__builtin_amdgcn_mbcnt_hi(~0u, __builtin_amdgcn_mbcnt_lo(~0u, 0u)); }
struct Frame {
    LAS unsigned char* lds; int tid, wave, G, bid;
    const float *x, *g_attn, *w_in, *b_forget, *g_fox, *g_sb, *w_out, *g_ffn, *w_router, *b_router, *w_gu, *b_gu, *w_d, *b_d, *g_final;
    float* out; unsigned char* ws;
};

typedef float f32x2_g __attribute__((ext_vector_type(2))); typedef __bf16 bf16x2_g __attribute__((ext_vector_type(2)));
__device__ __forceinline__ unsigned cvtpk2(float lo, float hi) { f32x2_g v = {lo, hi}; bf16x2_g r = __builtin_convertvector(v, bf16x2_g); return __builtin_bit_cast(unsigned, r); }
__device__ __forceinline__ void transpose_item(const float* W, int ldw, int K, bf16* WT, int item, int nblk, LAS unsigned* scr, int lane, const float* ks = nullptr, const float* ks2 = nullptr) {
    const int kb = item / nblk, nb = item % nblk, k0 = 64 * kb, n0 = 64 * nb, ng = lane & 15, kp = lane >> 4;
    f32x4 a[8], b[8];
#pragma unroll
    for (int i = 0; i < 8; ++i) { const float* p = W + (size_t)(k0 + 8 * i + 2 * kp) * ldw + n0 + 4 * ng; a[i] = __builtin_nontemporal_load((const f32x4*)p); b[i] = __builtin_nontemporal_load((const f32x4*)(p + ldw)); }
    if (ks) { const float* kq = (k0 < 512) ? ks + k0 : ks2 + (k0 - 512);
#pragma unroll
        for (int i = 0; i < 8; ++i) { a[i] = a[i] * kq[8 * i + 2 * kp]; b[i] = b[i] * kq[8 * i + 2 * kp + 1]; } }
#pragma unroll
    for (int i = 0; i < 8; ++i)
#pragma unroll
        for (int j = 0; j < 4; ++j) scr[(4 * ng + j) * 34 + 4 * i + kp] = cvtpk2(a[i][j], b[i][j]);
    LDS_WAIT(); asm volatile("" ::: "memory");
    const int c = lane & 7, rr = lane >> 3;
#pragma unroll
    for (int g = 0; g < 8; ++g) { const int n = 8 * g + rr; const v2u lo = *(const LAS v2u*)(scr + n * 34 + 4 * c), hi = *(const LAS v2u*)(scr + n * 34 + 4 * c + 2);
        *(GAS v4u*)(WT + (size_t)(n0 + n) * K + k0 + 8 * c) = (v4u){lo.x, lo.y, hi.x, hi.y}; }
    LDS_WAIT(); asm volatile("" ::: "memory");
}
__device__ __forceinline__ void transpose_item_fp8(const float* W, int ldw, int K, unsigned char* WT, int item, int nblk, LAS unsigned* scr, int lane, float scale) {
    const int kb = item / nblk, nb = item % nblk, k0 = 128 * kb, n0 = 32 * nb, ng = lane & 7, kq = lane >> 3;
    f32x4 r[4][4];
#pragma unroll
    for (int i = 0; i < 4; ++i)
#pragma unroll
        for (int q = 0; q < 4; ++q) r[i][q] = __builtin_nontemporal_load((const f32x4*)(W + (size_t)(k0 + 32 * i + 4 * kq + q) * ldw + n0 + 4 * ng));
#pragma unroll
    for (int i = 0; i < 4; ++i)
#pragma unroll
        for (int j = 0; j < 4; ++j) scr[(4 * ng + j) * 34 + 8 * i + kq] = pg8::cvt4_fp8(r[i][0][j] * scale, r[i][1][j] * scale, r[i][2][j] * scale, r[i][3][j] * scale);
    LDS_WAIT(); asm volatile("" ::: "memory");
    const int c = lane & 7, rr = lane >> 3;
#pragma unroll
    for (int g = 0; g < 4; ++g) { const int n = rr + 8 * g; const v2u lo = *(const LAS v2u*)(scr + n * 34 + 4 * c), hi = *(const LAS v2u*)(scr + n * 34 + 4 * c + 2);
        *(GAS v4u*)(WT + (size_t)(n0 + n) * K + k0 + 16 * c) = (v4u){lo.x, lo.y, hi.x, hi.y}; }
    LDS_WAIT(); asm volatile("" ::: "memory");
}
__device__ __forceinline__ void p0_prologue(Frame& F) {
    LAS unsigned* scr = (LAS unsigned*)(F.lds + F.wave * 16384);
    const int gw = F.bid * NWAVES + F.wave, NGW = F.G * NWAVES;
    bf16* Win_t = (bf16*)(F.ws + WS_WIN); bf16* Wout_t = (bf16*)(F.ws + WS_WOUT); bf16* Wgu_t = (bf16*)(F.ws + WS_WGU); bf16* Wd_t = (bf16*)(F.ws + WS_WD);
    constexpr int I_IN = 16 * 8, I_OUT = 16 * 16, I_GU = 8 * 64, I_D = 8 * 32;
    constexpr int NITEMS = 6 * I_IN + I_OUT;
    for (int it = gw; it < NITEMS; it += NGW) {
        int r = it;
        if (r < 6 * I_IN) { const int seg = r / I_IN; r -= seg * I_IN;
            const int src = (seg == 0) ? 0 : (seg == 1) ? 1544 : (seg == 2) ? 512 : (seg == 3) ? 2056 : (seg == 4) ? 1024 : 2568;
            transpose_item(F.w_in + src, INC, D, Win_t + (size_t)seg * 512 * D, r, 8, scr, hw_lane(), F.g_attn, F.g_attn + 512); continue; }
        r -= 6 * I_IN;
        transpose_item(F.w_out, D, D, Wout_t, r, 16, scr, hw_lane(), F.g_fox, F.g_sb);
    }
    __syncthreads();
    LAS float* Wf = (LAS float*)F.lds;
    for (int i = F.tid; i < D * 8; i += NTHR) Wf[i] = F.w_in[(size_t)(i >> 3) * INC + 1536 + (i & 7)];
    __syncthreads();
    bf16* XN = (bf16*)(F.ws + WS_XN); float* LOGF = (float*)(F.ws + WS_LOGF); float* RS0 = (float*)(F.ws + WS_RS0);
    { const int ln = hw_lane();
      const float bfg = F.b_forget[ln & 7];
      f32x4 gq[4], v[4], nv[4];
#pragma unroll
      for (int j = 0; j < 4; ++j) { gq[j] = *((const GAS f32x4*)F.g_attn + ln + 64 * j); nv[j] = (f32x4){0.f, 0.f, 0.f, 0.f}; }
      if (gw < M) { const GAS f32x4* xr = (const GAS f32x4*)(F.x + (size_t)gw * D) + ln;
#pragma unroll
          for (int j = 0; j < 4; ++j) v[j] = xr[64 * j]; }
      float s = 0.f;
#pragma unroll
      for (int j = 0; j < 4; ++j) s += (v[j].x * v[j].x + v[j].y * v[j].y) + (v[j].z * v[j].z + v[j].w * v[j].w);
      for (int m = gw; m < M; m += NGW) {
        { const int mn = (m + NGW < M) ? m + NGW : m;
          const GAS f32x4* xr = (const GAS f32x4*)(F.x + (size_t)mn * D) + ln;
#pragma unroll
          for (int j = 0; j < 4; ++j) nv[j] = xr[64 * j]; }
        const float rs = 1.0f / sqrtf(wave_sum(s) * (1.f / D) + EPS);
        float fa[8];
#pragma unroll
        for (int h = 0; h < 8; ++h) fa[h] = 0.f;
        GAS unsigned long long* o8 = (GAS unsigned long long*)(XN + (size_t)m * D) + ln;
        if (ln == 0) RS0[m] = rs;
#pragma unroll
        for (int j = 0; j < 4; ++j) { o8[64 * j] = (unsigned long long)pk2(v[j].x, v[j].y) | ((unsigned long long)pk2(v[j].z, v[j].w) << 32);
            v[j] = v[j] * rs * gq[j];
#pragma unroll
            for (int i = 0; i < 4; ++i) { const int k = 4 * ln + 256 * j + i; const f32x4 w0 = *(const LAS f32x4*)(Wf + k * 8), w1 = *(const LAS f32x4*)(Wf + k * 8 + 4); const float hv = v[j][i];
                fa[0] += hv * w0.x; fa[1] += hv * w0.y; fa[2] += hv * w0.z; fa[3] += hv * w0.w; fa[4] += hv * w1.x; fa[5] += hv * w1.y; fa[6] += hv * w1.z; fa[7] += hv * w1.w; } }
#pragma unroll
        for (int h = 0; h < 8; ++h) fa[h] = wave_sum(fa[h]);
        if (ln < 8) { float f = fa[0];
#pragma unroll
            for (int h = 1; h < 8; ++h) f = (ln == h) ? fa[h] : f;
            f += bfg;
            const float lf = fminf(f, 0.f) - log1pf(expf(-fabsf(f)));
            const int b = m / SEQ, s_ = m % SEQ; LOGF[(size_t)(b * 8 + ln) * SEQ + s_] = lf; }
        s = 0.f;
#pragma unroll
        for (int j = 0; j < 4; ++j) { v[j] = nv[j]; s += (v[j].x * v[j].x + v[j].y * v[j].y) + (v[j].z * v[j].z + v[j].w * v[j].w); }
      } }
    __syncthreads();
}

constexpr int WPH = 1032;
__device__ __forceinline__ void stage_router(const float* w_router, const float* g_ffn, LAS unsigned short* Wh, int t, int nt) {
    LAS unsigned short* Wl = Wh + NE * WPH;
    for (int i0 = t; i0 < D * NE / 4; i0 += 6 * nt) { f32x4 wv[6];
#pragma unroll
        for (int u = 0; u < 6; ++u) { const int i = i0 + u * nt; if (i < D * NE / 4) wv[u] = ((const GAS f32x4*)w_router)[i]; }
#pragma unroll
        for (int u = 0; u < 6; ++u) { const int i = i0 + u * nt; if (i < D * NE / 4) { const int k = i >> 3, e0 = (i & 7) * 4; const f32x4 w = wv[u] * g_ffn[k];
#pragma unroll
            for (int j = 0; j < 4; ++j) { const unsigned h = f2bf(w[j]); const float lo = w[j] - __uint_as_float(h << 16); Wh[(e0 + j) * WPH + k] = (unsigned short)h; Wl[(e0 + j) * WPH + k] = (unsigned short)f2bf(lo); } } } }
}

__global__ void __launch_bounds__(NTHR, 2) fwd_kernel(Args args) {
    extern __shared__ __attribute__((aligned(16))) unsigned char lds[];
    Frame F;
    F.lds = (LAS unsigned char*)lds; F.tid = threadIdx.x; F.wave = __builtin_amdgcn_readfirstlane(F.tid >> 6); F.G = gridDim.x; F.bid = blockIdx.x;
    F.x = args.in[0]; F.g_attn = args.in[1]; F.w_in = args.in[2]; F.b_forget = args.in[3]; F.g_fox = args.in[4]; F.g_sb = args.in[5]; F.w_out = args.in[6]; F.g_ffn = args.in[7];
    F.w_router = args.in[8]; F.b_router = args.in[9]; F.w_gu = args.in[10]; F.b_gu = args.in[11]; F.w_d = args.in[12]; F.b_d = args.in[13]; F.g_final = args.in[14];
    F.out = args.out; F.ws = args.ws;
    volatile LAS unsigned* MISC = (volatile LAS unsigned*)(F.lds + MISC_OFF);
    for (int u = F.tid; u < (LDS_BYTES - 131072) / 4; u += NTHR) ((LAS unsigned*)(F.lds + 131072))[u] = 0u;
    __syncthreads();
    unsigned* ctl = (unsigned*)(F.ws + WS_CTL);
    XcdBarrier bar = xcd_barrier_post(ctl + CW_BAR, MISC + 8);
    if (threadIdx.x == 0 && (F.G % 8 != 0 || bar.x != (unsigned)(F.bid % 8))) atomicOr(ctl + CW_MAPBAD, 1u);
    const int lo = args.ph_lo, hi = args.ph_hi;
#define IN(k) (lo <= (k) && (k) < hi)
#define SEAM(k) do { if (IN(k) && IN((k) + 1)) xcd_barrier(bar); } while (0)
    LAS float* As = (LAS float*)F.lds;

    if (IN(0)) { p0_prologue(F); }
    SEAM(0);
    if (IN(1)) {
        for (int j = F.bid; j < 16; j += F.G) {
            const float* lf = (const float*)(F.ws + WS_LOGF) + (size_t)j * SEQ; float* cl = (float*)(F.ws + WS_CL) + (size_t)j * SEQ;
            LAS float* part = (LAS float*)F.lds;
            float v[16]; float s = 0.f;
#pragma unroll
            for (int i = 0; i < 16; ++i) { s += lf[F.tid * 16 + i]; v[i] = s; }
            __syncthreads(); part[F.tid] = s; __syncthreads();
            if (F.tid == 0) { float run = 0.f; for (int i = 0; i < NTHR; ++i) { const float tmp = part[i]; part[i] = run; run += tmp; } }
            __syncthreads();
            const float base = part[F.tid];
#pragma unroll
            for (int i = 0; i < 16; ++i) cl[F.tid * 16 + i] = (base + v[i]) * LOG2E;
            __syncthreads();
        }
        __syncthreads();
        { pg8::Gemm g{(const bf16*)(F.ws + WS_XN), (const bf16*)(F.ws + WS_WIN), M, 3 * D, D}; pg8::StaticOrder S; S.init(M, 3 * D, F.G, F.bid);
          pg8::EpiQKV E{(bf16*)(F.ws + WS_Q), (size_t)(WS_K - WS_Q) / 2, C2, ctl + CW_KN, (const float*)(F.ws + WS_RS0)};
          pg8::gemm_phase<pg8::EpiQKV, pg8::StaticOrder, true, true>(F.lds, g, S, E); }
    }
    SEAM(1);
    if (IN(2)) {
        const int v0 = (F.G % 8 == 0) ? (F.bid % 8) * (F.G / 8) + F.bid / 8 : F.bid;
        if (F.tid == 16) *(LAS unsigned*)(F.lds + MISC_OFF) = 0u;
        if (F.tid < 16) { ((LAS unsigned*)(F.lds + att::G_DONE))[F.tid] = 0u; ((LAS unsigned*)(F.lds + att::G_ARR))[F.tid] = 0u;
                          ((LAS unsigned*)(F.lds + att::G_BYTES + att::G_DONE))[F.tid] = 0u; ((LAS unsigned*)(F.lds + att::G_BYTES + att::G_ARR))[F.tid] = 0u; }
        __syncthreads();
        const bf16* QO = (const bf16*)(F.ws + WS_Q); bf16* OB = (bf16*)(F.ws + WS_O); const bf16* KB = (const bf16*)(F.ws + WS_K); const bf16* VB = (const bf16*)(F.ws + WS_V); float* SSQ = (float*)(F.ws + WS_SSQ);
        bf16* Wgu_t = (bf16*)(F.ws + WS_WGU); bf16* Wd_t = (bf16*)(F.ws + WS_WD);
        constexpr int I_GU = 8 * 64, I_D = 8 * 32;
        unsigned epoch = 0u;
        if (F.wave < 4) { __builtin_amdgcn_s_setprio(3);
            for (int v = v0; v < 256; v += F.G) {
                const int bh = v >> 4, s_ = v & 15, b = bh >> 3, h = bh & 7;
                const float KN = sqrtf(__uint_as_float(ctl[CW_KN + (b * 16 + h) * 2]) + __uint_as_float(ctl[CW_KN + (b * 16 + h) * 2 + 1])) * 1.02f;
                const float* CLrow = (const float*)(F.ws + WS_CL) + (size_t)(b * 8 + h) * SEQ;
#pragma unroll 1
                for (int u = 0; u < 4; ++u) { const int qb = (u == 0) ? 63 - s_ : (u == 1) ? 47 - s_ : (u == 2) ? 16 + s_ : s_;
                    att::attn_unit4<true, ATT_PRUNE != 0>(b, h, qb, QO, OB, KB, VB, SSQ, CLrow, KN, (char*)lds, epoch);
                    if (u < 2) att::attn_unit4<false, ATT_PRUNE != 0>(b, 8 + h, qb, QO, OB, KB, VB, SSQ, nullptr, 0.f, (char*)lds, epoch); }
            }
            __builtin_amdgcn_s_setprio(0);
        } else {
            for (int v = v0; v < 256; v += F.G) {
                const int bh = v >> 4, s_ = v & 15, b = bh >> 3, h = bh & 7;
#pragma unroll 1
                for (int u = 2; u < 4; ++u) { const int qb = (u == 2) ? 16 + s_ : s_;
                    att::attn_unit4<false, ATT_PRUNE != 0>(b, 8 + h, qb, QO, OB, KB, VB, SSQ, nullptr, 0.f, (char*)lds + att::G_BYTES, epoch); }
            }
        }
        { const int gsel = F.wave >> 2;
          asm volatile("s_waitcnt vmcnt(0) lgkmcnt(0)" ::: "memory");
          att::grp_barrier((att::lds_vu32)(F.lds + gsel * att::G_BYTES + att::G_ARR), epoch, F.wave & 3, hw_lane());
          LAS unsigned* scr = (LAS unsigned*)(F.lds + gsel * att::G_BYTES + (F.wave & 3) * 4608);
          for (;;) {
              int n = 0; if (hw_lane() == 0) n = (int)__hip_atomic_fetch_add((LAS unsigned*)(F.lds + MISC_OFF), 1u, __ATOMIC_RELAXED, __HIP_MEMORY_SCOPE_WORKGROUP);
              n = __builtin_amdgcn_readfirstlane(n);
              int r = v0 * 8 + (n & 7) + (n >> 3) * 8 * F.G;
              if (r >= NE * (I_GU + I_D)) break;
              if (r < NE * I_GU) { const int e = r / I_GU; r -= e * I_GU; transpose_item_fp8(F.w_gu + (size_t)e * D * 2 * DFF, 2 * DFF, D, (unsigned char*)Wgu_t + (size_t)e * 2 * DFF * D, r, 64, scr, hw_lane(), W8_SCALE); }
              else { r -= NE * I_GU; const int e = r / I_D; r -= e * I_D; transpose_item_fp8(F.w_d + (size_t)e * DFF * D, D, DFF, (unsigned char*)Wd_t + (size_t)e * D * DFF, r, 32, scr, hw_lane(), W8_SCALE); }
          } }
        __syncthreads();
    }
    SEAM(2);
    if (IN(4)) {
        pg8::Gemm g{(const bf16*)(F.ws + WS_O), (const bf16*)(F.ws + WS_WOUT), M, D, D}; pg8::StaticOrder S; S.init(M, D, F.G, F.bid);
        pg8::EpiResMid E{(const unsigned short*)(F.ws + WS_XN), (unsigned short*)(F.ws + WS_X1), D, (const float*)(F.ws + WS_SSQ), (LAS float*)(F.lds + 131072)};
        pg8::gemm_phase<pg8::EpiResMid, pg8::StaticOrder, true, true>(F.lds, g, S, E);
    }
    if (IN(4) && IN(5)) xcd_barrier_work(bar, [&]() { stage_router(F.w_router, F.g_ffn, (LAS unsigned short*)F.lds, (int)threadIdx.x - 64, NTHR - 64); });
    if (IN(5)) {
        unsigned char* H8 = (unsigned char*)(F.ws + WS_XN); int* TOPE = (int*)(F.ws + WS_TOPE); float* GATE = (float*)(F.ws + WS_GATE); int* CNT = (int*)(F.ws + WS_CNT); const unsigned short* X1 = (const unsigned short*)(F.ws + WS_X1);
        LAS unsigned short* Wh = (LAS unsigned short*)F.lds;
        LAS float* Lg = (LAS float*)(F.lds + 2 * NE * WPH * 2);
        LAS float* RS = Lg + 64 * 32;
        LAS int* hist = (LAS int*)(RS + 64);
        __syncthreads();
        if (!IN(4)) stage_router(F.w_router, F.g_ffn, Wh, F.tid, NTHR);
        const int ln = hw_lane(), mt = F.wave >> 1, kh = F.wave & 1, r16 = ln & 15, kq = ln >> 4;
        const float brt0 = F.b_router[r16], brt1 = F.b_router[16 + r16];
        LAS float* Pp = Lg;
        f32x4 gq5[4];
#pragma unroll
        for (int j = 0; j < 4; ++j) gq5[j] = *((const GAS f32x4*)F.g_ffn + ln + 64 * j);
        for (int vb = F.bid; vb < NVB; vb += F.G) {
            __syncthreads(); if (F.tid < NE) hist[F.tid] = 0;
            { typedef short s16x8 __attribute__((ext_vector_type(8)));
              const GAS s16x8* xrow = (const GAS s16x8*)(X1 + (size_t)(vb * VBT + mt * 16 + r16) * D + 512 * kh + 8 * kq); const LAS s16x8* wrow = (const LAS s16x8*)(Wh + r16 * WPH + 512 * kh + 8 * kq);
              f32x4 acc0 = {0.f, 0.f, 0.f, 0.f}, acc1 = {0.f, 0.f, 0.f, 0.f}; float ssq = 0.f;
              s16x8 ax[16];
#pragma unroll
              for (int i = 0; i < 16; ++i) ax[i] = xrow[4 * i];
#pragma unroll
              for (int i = 0; i < 16; ++i) { const s16x8 a = ax[i];
                  const s16x8 bh0 = wrow[4 * i], bh1 = wrow[4 * i + 16 * WPH / 8], bl0 = wrow[4 * i + NE * WPH / 8], bl1 = wrow[4 * i + (NE + 16) * WPH / 8];
#pragma unroll
                  for (int t = 0; t < 8; ++t) { const float xf = __uint_as_float((unsigned)(unsigned short)a[t] << 16); ssq += xf * xf; }
                  acc0 = __builtin_amdgcn_mfma_f32_16x16x32_bf16(a, bl0, acc0, 0, 0, 0); acc1 = __builtin_amdgcn_mfma_f32_16x16x32_bf16(a, bl1, acc1, 0, 0, 0);
                  acc0 = __builtin_amdgcn_mfma_f32_16x16x32_bf16(a, bh0, acc0, 0, 0, 0); acc1 = __builtin_amdgcn_mfma_f32_16x16x32_bf16(a, bh1, acc1, 0, 0, 0); }
              ssq += __shfl_xor(ssq, 16); ssq += __shfl_xor(ssq, 32);
              if (kh == 1) { *(LAS f32x4*)(Pp + ((mt * 2 + 0) * 64 + ln) * 4) = acc0; *(LAS f32x4*)(Pp + ((mt * 2 + 1) * 64 + ln) * 4) = acc1; if (kq == 0) RS[mt * 16 + r16] = ssq; }
              __syncthreads();
              if (kh == 0) { const f32x4 q0 = *(const LAS f32x4*)(Pp + ((mt * 2 + 0) * 64 + ln) * 4), q1 = *(const LAS f32x4*)(Pp + ((mt * 2 + 1) * 64 + ln) * 4);
                  acc0 = acc0 + q0; acc1 = acc1 + q1; ssq += RS[mt * 16 + r16];
                  const float rsr = 1.0f / sqrtf(ssq * (1.f / D) + EPS);
                  if (kq == 0) RS[mt * 16 + r16] = rsr;
#pragma unroll
                  for (int j = 0; j < 4; ++j) { const int row = 4 * kq + j; const float rsj = __shfl(rsr, row);
                      Lg[(mt * 16 + row) * 32 + r16] = acc0[j] * rsj + brt0; Lg[(mt * 16 + row) * 32 + 16 + r16] = acc1[j] * rsj + brt1; } } }
            __syncthreads();
            float msv[TOPK] = {0.f, 0.f, 0.f, 0.f}; int msi[TOPK] = {0, 0, 0, 0};
            for (int rr = 0; rr < VBT / NWAVES; ++rr) {
                const int row = F.wave * (VBT / NWAVES) + rr, m = vb * VBT + row;
                const GAS v2u_b* xr = (const GAS v2u_b*)(X1 + (size_t)m * D) + ln;
                f32x4 v[4];
#pragma unroll
                for (int j = 0; j < 4; ++j) v[j] = bf4(xr[64 * j]);
                float vv = Lg[row * 32 + (ln & 31)];
                float sv[TOPK]; int si[TOPK];
#pragma unroll
                for (int r = 0; r < TOPK; ++r) {
                    float mq = vv;
                    mq = fmaxf(mq, __builtin_bit_cast(float, __builtin_amdgcn_update_dpp(0, __builtin_bit_cast(int, mq), 0xB1, 0xF, 0xF, true)));
                    mq = fmaxf(mq, __builtin_bit_cast(float, __builtin_amdgcn_update_dpp(0, __builtin_bit_cast(int, mq), 0x4E, 0xF, 0xF, true)));
                    mq = fmaxf(mq, __builtin_bit_cast(float, __builtin_amdgcn_update_dpp(0, __builtin_bit_cast(int, mq), 0x141, 0xF, 0xF, true)));
                    mq = fmaxf(mq, __builtin_bit_cast(float, __builtin_amdgcn_update_dpp(0, __builtin_bit_cast(int, mq), 0x140, 0xF, 0xF, true)));
                    const float mx = fmaxf(__builtin_bit_cast(float, __builtin_amdgcn_readlane(__builtin_bit_cast(int, mq), 0)), __builtin_bit_cast(float, __builtin_amdgcn_readlane(__builtin_bit_cast(int, mq), 16)));
                    const unsigned long long mk = __ballot(vv == mx); const int li = __builtin_amdgcn_readfirstlane((int)__builtin_ctzll(mk));
                    si[r] = li; sv[r] = mx;
                    if ((ln & 31) == li) vv = -INFINITY; }
#pragma unroll
                for (int r = 0; r < TOPK; ++r) { if (ln == rr) { msv[r] = sv[r]; msi[r] = si[r]; } }
                const float rs = RS[row] * X8_SCALE;
                GAS unsigned* o4 = (GAS unsigned*)(H8 + (size_t)m * D) + ln;
#pragma unroll
                for (int j = 0; j < 4; ++j) { const f32x4 h = v[j] * rs * gq5[j]; o4[64 * j] = pg8::cvt4_fp8(h.x, h.y, h.z, h.w); }
            }
            if (ln < VBT / NWAVES) { const int m = vb * VBT + F.wave * (VBT / NWAVES) + ln;
                const float x1_ = expf(msv[1] - msv[0]), x2_ = expf(msv[2] - msv[0]), x3_ = expf(msv[3] - msv[0]); const float inv = 1.f / (1.f + x1_ + x2_ + x3_);
                *(GAS f32x4*)(GATE + (size_t)m * 4) = (f32x4){inv, x1_ * inv, x2_ * inv, x3_ * inv};
                *(GAS v4u*)(TOPE + (size_t)m * 4) = (v4u){(unsigned)msi[0], (unsigned)msi[1], (unsigned)msi[2], (unsigned)msi[3]};
                atomicAdd((int*)&hist[msi[0]], 1); atomicAdd((int*)&hist[msi[1]], 1); atomicAdd((int*)&hist[msi[2]], 1); atomicAdd((int*)&hist[msi[3]], 1); }
            __syncthreads();
            if (F.tid < NE) CNT[vb * NE + F.tid] = hist[F.tid];
        }
        __syncthreads();
    }
    SEAM(5);
    if (IN(6)) {
        const int* TOPE = (const int*)(F.ws + WS_TOPE); const float* GATE = (const float*)(F.ws + WS_GATE); const int* CNT = (const int*)(F.ws + WS_CNT);
        int* ROWTOK = (int*)(F.ws + WS_ROWTOK); int* ROWDST = (int*)(F.ws + WS_ROWDST); float* GSLOT = (float*)(F.ws + WS_GSLOT2); int* TILE = (int*)(F.ws + WS_TILE);
        LAS int* es = (LAS int*)F.lds; LAS int* tot = es + 256; LAS int* bef = tot + 32; LAS int* ps = bef + 32; LAS int* part = ps + 32;
        for (int vb = F.bid; vb < NVB; vb += F.G) {
            __syncthreads();
            float gate_ = 0.f;
            if (F.tid < 256) { es[F.tid] = TOPE[(size_t)vb * VBT * 4 + F.tid]; gate_ = GATE[(size_t)vb * VBT * 4 + F.tid]; }
            { const int e = F.tid & 31, qg = F.tid >> 5; int cv[16];
#pragma unroll
              for (int i = 0; i < 16; ++i) cv[i] = CNT[(qg * 16 + i) * NE + e];
              int t_ = 0, b_ = 0;
#pragma unroll
              for (int i = 0; i < 16; ++i) { t_ += cv[i]; b_ += (qg * 16 + i < vb) ? cv[i] : 0; }
              part[qg * 32 + e] = t_; part[512 + qg * 32 + e] = b_; }
            __syncthreads();
            if (F.tid < NE) { int t_ = 0, b_ = 0;
#pragma unroll
                for (int qg = 0; qg < 16; ++qg) { t_ += part[qg * 32 + F.tid]; b_ += part[512 + qg * 32 + F.tid]; }
                tot[F.tid] = t_; bef[F.tid] = b_; }
            __syncthreads();
            if (F.tid < NE) { int nt = 0;
                for (int e = 0; e < F.tid; ++e) nt += (tot[e] + 255) / 256;
                ps[F.tid] = nt * 256;
                if (F.tid == NE - 1) MISC[16] = (unsigned)(nt + (tot[F.tid] + 255) / 256);
                if (vb == NE) { const int k = (tot[F.tid] + 255) / 256; for (int i = 0; i < k; ++i) TILE[16 + nt + i] = F.tid; if (F.tid == NE - 1) TILE[0] = nt + k; } }
            __syncthreads();
            if (F.tid < 256) { const int e = es[F.tid]; int rank = 0;
#pragma unroll 8
                for (int j4 = 0; j4 < 64; ++j4) { const v4u q = *(const LAS v4u*)(es + 4 * j4); const int j = 4 * j4;
                    rank += ((int)q.x == e && j < F.tid) + ((int)q.y == e && j + 1 < F.tid) + ((int)q.z == e && j + 2 < F.tid) + ((int)q.w == e && j + 3 < F.tid); }
                const int slot = ps[e] + bef[e] + rank; const int a = vb * VBT * 4 + F.tid; ROWTOK[slot] = a >> 2; ROWDST[slot] = a; GSLOT[slot] = gate_;  }
            if (vb < NE) {
                const int n0 = ps[vb] + tot[vb], n1 = ps[vb] + (tot[vb] + 255) / 256 * 256;
                for (int r = n0 + F.tid; r < n1; r += NTHR) { ROWTOK[r] = 0; ROWDST[r] = -1; GSLOT[r] = 0.f; } }
        }
    }
    SEAM(6);
    if (IN(7)) {
        pg8::Gemm g{(const bf16*)(F.ws + WS_XN), (const bf16*)(F.ws + WS_WGU), MAXROWS, 2 * DFF, D / 2}; pg8::GroupedOrderT<1> S; S.init((const int*)(F.ws + WS_TILE), 8, F.G, F.bid, ctl + CW_TC, 0u, 0, __builtin_amdgcn_readfirstlane((int)MISC[16]));
        pg8::EpiSwiglu E{(unsigned char*)(F.ws + WS_ACT), F.b_gu, 1.f / (X8_SCALE * W8_SCALE), A8_SCALE};
        pg8::gemm_phase<pg8::EpiSwiglu, pg8::GroupedOrderT<1>, true, true, true, true>(F.lds, g, S, E, (const int*)(F.ws + WS_ROWTOK));
    }
    if (IN(7) && IN(8)) { if (__builtin_amdgcn_readfirstlane((int)__hip_atomic_load(ctl + CW_MAPBAD, __ATOMIC_RELAXED, __HIP_MEMORY_SCOPE_AGENT)) != 0) xcd_barrier(bar); }
    if (IN(8)) {
        pg8::Gemm g{(const bf16*)(F.ws + WS_ACT), (const bf16*)(F.ws + WS_WD), MAXROWS, D, DFF / 2}; pg8::GroupedOrderT<2> S; S.init((const int*)(F.ws + WS_TILE), 4, F.G, F.bid, ctl + CW_TC, 8u * NWAVES, 8, __builtin_amdgcn_readfirstlane((int)MISC[16]));
        pg8::EpiDownG E{(unsigned char*)(F.ws + WS_XS), F.b_d, (const float*)(F.ws + WS_GSLOT2), (const int*)(F.ws + WS_ROWDST), 1.f / (A8_SCALE * W8_SCALE), Y8_SCALE};
        pg8::gemm_phase<pg8::EpiDownG, pg8::GroupedOrderT<2>, true, true, false, true>(F.lds, g, S, E);
    }
    SEAM(8);
    if (IN(9)) {
        const bf16* Y = (const bf16*)(F.ws + WS_XS);
        const int gw = F.bid * NWAVES + F.wave, NGW = F.G * NWAVES;
        f32x4 gq9[4];
#pragma unroll
        for (int j = 0; j < 4; ++j) gq9[j] = *((const GAS f32x4*)F.g_final + hw_lane() + 64 * j);
        for (int m = gw; m < M; m += NGW) {
            GAS f32x4* xr = (GAS f32x4*)(F.out + (size_t)m * D) + hw_lane(); const GAS v2u_b* x1r = (const GAS v2u_b*)((const unsigned short*)(F.ws + WS_X1) + (size_t)m * D) + hw_lane();
            f32x4 v[4];
#pragma unroll
            for (int j = 0; j < 4; ++j) v[j] = bf4(x1r[64 * j]);
#pragma unroll
            for (int k = 0; k < TOPK; ++k) { const GAS unsigned* yr = (const GAS unsigned*)((const unsigned char*)Y + ((size_t)m * 4 + k) * D) + hw_lane();
#pragma unroll
                for (int j = 0; j < 4; ++j) { const unsigned w = yr[64 * j]; typedef float f2_ __attribute__((ext_vector_type(2))); const f2_ lo = __builtin_amdgcn_cvt_pk_f32_fp8((int)w, false), hi = __builtin_amdgcn_cvt_pk_f32_fp8((int)w, true);
                    v[j].x += lo.x * (1.f / Y8_SCALE); v[j].y += lo.y * (1.f / Y8_SCALE); v[j].z += hi.x * (1.f / Y8_SCALE); v[j].w += hi.y * (1.f / Y8_SCALE); } }
            float s = 0.f;
#pragma unroll
            for (int j = 0; j < 4; ++j) s += (v[j].x * v[j].x + v[j].y * v[j].y) + (v[j].z * v[j].z + v[j].w * v[j].w);
            const float rs = 1.0f / sqrtf(wave_sum(s) * (1.f / D) + EPS);
#pragma unroll
            for (int j = 0; j < 4; ++j) xr[64 * j] = v[j] * rs * gq9[j];
        }
    }
#undef IN
#undef SEAM
}

extern "C" void kernel_launch(void* const* d_in, const int* in_sizes, int n_in, void* d_out, int out_size, void* d_ws, size_t ws_size, hipStream_t stream) {
    static int grid = 0;
    if (grid == 0) {
        if (n_in != 15 || out_size != M * D || ws_size < WS_END) { fprintf(stderr, "kernel_launch: unexpected problem (n_in %d out %d ws %zu)\n", n_in, out_size, ws_size); grid = -1; return; }
        int dev = 0, cus = 0, per_cu = 0;
        if (hipGetDevice(&dev) != hipSuccess || hipDeviceGetAttribute(&cus, hipDeviceAttributeMultiprocessorCount, dev) != hipSuccess) { grid = -1; return; }
        if (hipFuncSetAttribute((const void*)fwd_kernel, hipFuncAttributeMaxDynamicSharedMemorySize, LDS_BYTES) != hipSuccess) { fprintf(stderr, "kernel_launch: hipFuncSetAttribute failed\n"); grid = -1; return; }
        if (hipOccupancyMaxActiveBlocksPerMultiprocessor(&per_cu, (const void*)fwd_kernel, NTHR, LDS_BYTES) != hipSuccess || per_cu < 1) { fprintf(stderr, "kernel_launch: occupancy query says %d blocks/CU\n", per_cu); (void)hipGetLastError(); grid = -1; return; }
        grid = cus;
    }
    if (grid < 0) return;
    if (hipMemsetAsync((char*)d_ws + WS_CTL, 0, CTL_ZERO_BYTES, stream) != hipSuccess) return;
    Args a{};
    for (int i = 0; i < 15; ++i) a.in[i] = (const float*)d_in[i];
    a.out = (float*)d_out; a.ws = (unsigned char*)d_ws; a.ph_lo = 0; a.ph_hi = 10;
    hipLaunchKernelGGL(fwd_kernel, dim3(grid), dim3(NTHR), LDS_BYTES, stream, a);
}
```
